# Optimizing an MI355X kernel written in HIP

```python
import math
import jax, jax.numpy as jnp
from jax import lax
import numpy as np

D_MODEL = 1024
BATCH = 4
SEQ = 8192
DEPTH = 1

MIX_WIDTH = D_MODEL
ATTN_WIDTH = MIX_WIDTH // 2
SSM_WIDTH = MIX_WIDTH - ATTN_WIDTH
HEAD_DIM = 64
N_HEADS = ATTN_WIDTH // HEAD_DIM
DILATED_BRANCHES = ((128, 1), (512, 4), (2048, 16))
BLOCK = 128
SSM_GROUP = 16
N_SSM_GROUPS = SSM_WIDTH // SSM_GROUP
STATE_DIM = 64
D_FF = 2816
IN_WIDTH = 3 * ATTN_WIDTH + SSM_WIDTH
NORM_EPS = 1e-6
DT_MIN = 1e-3
DT_MAX = 1e-1

kernel_name = "hybrid_dilated_alibi_attn_s5_macaron_layer"


def rms_norm(x, g):
    xf = x.astype(jnp.float32)
    y = xf * lax.rsqrt(jnp.mean(xf * xf, axis=-1, keepdims=True) + NORM_EPS)
    return (y * g.astype(jnp.float32)).astype(x.dtype)


def swiglu(x, w_in, w_out):
    gate, up = jnp.split(x @ w_in, 2, axis=-1)
    return (jax.nn.silu(gate) * up) @ w_out


def alibi_slopes(n_heads):
    return 2.0 ** (-8.0 * jnp.arange(1, n_heads + 1, dtype=jnp.float32) / n_heads)


def dilated_window_branch(q, k, v, slopes, window, dilation):
    B, S, H, E = q.shape
    n_back = window // dilation
    L = -(-S // dilation)
    nb = -(-L // BLOCK)
    Lp = nb * BLOCK

    def to_blocks(t):
        t = jnp.pad(t, ((0, 0), (0, L * dilation - S), (0, 0), (0, 0)))
        t = t.reshape(B, L, dilation, H, E).transpose(0, 2, 1, 3, 4)
        t = jnp.pad(t, ((0, 0), (0, 0), (0, Lp - L), (0, 0), (0, 0)))
        return t.reshape(B, dilation, nb, BLOCK, H, E)

    def with_prev(t):
        prev = jnp.pad(t[:, :, :-1], ((0, 0), (0, 0), (1, 0), (0, 0), (0, 0), (0, 0)))
        return jnp.concatenate([prev, t], axis=3)

    def from_blocks(t):
        tail = t.shape[4:]
        t = t.reshape((B, dilation, Lp) + tail)[:, :, :L]
        t = jnp.moveaxis(t, 1, 2).reshape((B, L * dilation) + tail)
        return t[:, :S]

    qb, kb, vb = to_blocks(q), to_blocks(k), to_blocks(v)
    kk, vv = with_prev(kb), with_prev(vb)
    s = jnp.einsum('brnqhe,brnkhe->brnhqk', qb, kk) * (HEAD_DIM ** -0.5)

    qi = jnp.arange(BLOCK)[:, None]
    ci = jnp.arange(2 * BLOCK)[None, :]
    steps = BLOCK + qi - ci
    key_pos = (jnp.arange(nb)[:, None, None] - 1) * BLOCK + ci[None]
    valid = ((steps >= 0) & (steps <= n_back))[None] & (key_pos >= 0)
    dist = (steps * dilation).astype(jnp.float32)
    bias = -slopes[:, None, None] * dist[None]
    s = jnp.where(valid[None, None, :, None], s + bias, -jnp.inf)

    m = jnp.max(s, axis=-1, keepdims=True)
    p = jnp.exp(s - m)
    denom = jnp.sum(p, axis=-1, keepdims=True)
    o = jnp.einsum('brnhqk,brnkhe->brnqhe', p, vv)
    o = o * jnp.swapaxes(1.0 / denom[..., 0], -1, -2)[..., None]
    lse = jnp.swapaxes((m + jnp.log(denom))[..., 0], -1, -2)
    return from_blocks(o), from_blocks(lse)


def dilated_attention(q, k, v):
    B, S, _ = q.shape
    q, k, v = (t.astype(jnp.float32).reshape(B, S, N_HEADS, HEAD_DIM) for t in (q, k, v))
    slopes = alibi_slopes(N_HEADS)
    outs, lses = [], []
    for window, dilation in DILATED_BRANCHES:
        o, l = dilated_window_branch(q, k, v, slopes, window, dilation)
        outs.append(o)
        lses.append(l)
    w = jax.nn.softmax(jnp.stack(lses, axis=-1), axis=-1)
    o = jnp.einsum('bshn,nbshe->bshe', w, jnp.stack(outs, axis=0))
    return o.reshape(B, S, ATTN_WIDTH)


def s5_mixer(u, a_re, a_im, log_dt, b_re, b_im, c_re, c_im, d_skip, w_glu, b_glu):
    B, S, _ = u.shape
    f32 = jnp.float32
    uf = u.astype(f32).reshape(B, S, N_SSM_GROUPS, SSM_GROUP)
    dt = jnp.exp(log_dt.astype(f32))[:, None]
    a = lax.complex(a_re.astype(f32), a_im.astype(f32))
    a_bar = jnp.exp(dt * a)
    b = lax.complex(b_re.astype(f32), b_im.astype(f32))
    b_bar = ((a_bar - 1.0) / a)[..., None] * b
    bu = jnp.einsum('bsgc,gpc->bsgp', uf.astype(jnp.complex64), b_bar)
    a_seq = jnp.broadcast_to(a_bar, bu.shape)

    def combine(left, right):
        a_l, x_l = left
        a_r, x_r = right
        return a_r * a_l, a_r * x_l + x_r

    _, states = lax.associative_scan(combine, (a_seq, bu), axis=1)
    c = lax.complex(c_re.astype(f32), c_im.astype(f32))
    y = jnp.real(jnp.einsum('bsgp,gcp->bsgc', states, c))
    y = y + d_skip.astype(f32).reshape(N_SSM_GROUPS, SSM_GROUP) * uf
    y = jax.nn.gelu(y.reshape(B, S, SSM_WIDTH))
    return y * jax.nn.sigmoid(y @ w_glu.astype(f32) + b_glu.astype(f32))


def setup_inputs(seed: int = 0) -> dict:
    key = jax.random.key(seed)
    ks = jax.random.split(key, 24)
    f32 = jnp.float32
    L = DEPTH

    def nrm(k, shape, scale):
        return jax.random.normal(k, shape, f32) * scale

    def gain(k):
        return 1.0 + 0.05 * jax.random.normal(k, (L, D_MODEL), f32)

    n_idx = jnp.arange(STATE_DIM, dtype=f32)
    a_re = -0.5 + 0.01 * jax.random.normal(ks[9], (L, N_SSM_GROUPS, STATE_DIM), f32)
    a_im = math.pi * n_idx + 0.01 * jax.random.normal(ks[10], (L, N_SSM_GROUPS, STATE_DIM), f32)
    log_dt = jax.random.uniform(ks[11], (L, N_SSM_GROUPS), f32,
                                math.log(DT_MIN), math.log(DT_MAX))
    return {
        "x": jax.random.normal(ks[0], (BATCH, SEQ, D_MODEL), f32),
        "ffn1_pre_g": gain(ks[1]),
        "ffn1_w_in": nrm(ks[2], (L, D_MODEL, 2 * D_FF), D_MODEL ** -0.5),
        "ffn1_w_out": nrm(ks[3], (L, D_FF, D_MODEL), D_FF ** -0.5),
        "ffn1_post_g": gain(ks[4]),
        "mix_pre_g": gain(ks[5]),
        "w_mix_in": nrm(ks[6], (L, D_MODEL, IN_WIDTH), D_MODEL ** -0.5),
        "a_re": a_re,
        "a_im": a_im,
        "log_dt": log_dt,
        "b_re": nrm(ks[12], (L, N_SSM_GROUPS, STATE_DIM, SSM_GROUP), (2 * SSM_GROUP) ** -0.5),
        "b_im": nrm(ks[13], (L, N_SSM_GROUPS, STATE_DIM, SSM_GROUP), (2 * SSM_GROUP) ** -0.5),
        "c_re": nrm(ks[14], (L, N_SSM_GROUPS, SSM_GROUP, STATE_DIM), (2 * STATE_DIM) ** -0.5),
        "c_im": nrm(ks[15], (L, N_SSM_GROUPS, SSM_GROUP, STATE_DIM), (2 * STATE_DIM) ** -0.5),
        "d_skip": nrm(ks[16], (L, SSM_WIDTH), 1.0),
        "w_glu": nrm(ks[17], (L, SSM_WIDTH, SSM_WIDTH), SSM_WIDTH ** -0.5),
        "b_glu": nrm(ks[18], (L, SSM_WIDTH), 0.01),
        "w_mix_out": nrm(ks[19], (L, MIX_WIDTH, D_MODEL), MIX_WIDTH ** -0.5),
        "mix_post_g": gain(ks[20]),
        "ffn2_pre_g": gain(ks[21]),
        "ffn2_w_in": nrm(ks[22], (L, D_MODEL, 2 * D_FF), D_MODEL ** -0.5),
        "ffn2_w_out": nrm(ks[23], (L, D_FF, D_MODEL), D_FF ** -0.5),
        "ffn2_post_g": gain(ks[7]),
    }


def reference(x, ffn1_pre_g, ffn1_w_in, ffn1_w_out, ffn1_post_g, mix_pre_g, w_mix_in,
              a_re, a_im, log_dt, b_re, b_im, c_re, c_im, d_skip, w_glu, b_glu,
              w_mix_out, mix_post_g, ffn2_pre_g, ffn2_w_in, ffn2_w_out, ffn2_post_g):
    for l in range(DEPTH):
        h = rms_norm(x, ffn1_pre_g[l])
        x = x + 0.5 * rms_norm(swiglu(h, ffn1_w_in[l], ffn1_w_out[l]), ffn1_post_g[l])
        h = rms_norm(x, mix_pre_g[l])
        proj = h @ w_mix_in[l]
        q, k, v, u = jnp.split(proj, [ATTN_WIDTH, 2 * ATTN_WIDTH, 3 * ATTN_WIDTH], axis=-1)
        attn = dilated_attention(q, k, v).astype(x.dtype)
        ssm = s5_mixer(u, a_re[l], a_im[l], log_dt[l], b_re[l], b_im[l], c_re[l], c_im[l],
                       d_skip[l], w_glu[l], b_glu[l]).astype(x.dtype)
        mixed = jnp.concatenate([attn, ssm], axis=-1) @ w_mix_out[l]
        x = x + rms_norm(mixed, mix_post_g[l])
        h = rms_norm(x, ffn2_pre_g[l])
        x = x + 0.5 * rms_norm(swiglu(h, ffn2_w_in[l], ffn2_w_out[l]), ffn2_post_g[l])
    return x
```

```cpp
#include <hip/hip_runtime.h>
#include <hip/hip_cooperative_groups.h>
#include <cstdio>
#include <cstdint>
namespace pg8 {
#define PG8_LAS __attribute__((address_space(3)))
typedef unsigned short bf16_t;
typedef short bf16x8 __attribute__((ext_vector_type(8)));
typedef float f32x4 __attribute__((ext_vector_type(4)));
typedef unsigned u32x4 __attribute__((ext_vector_type(4)));
constexpr int BM = 256, BK = 64, HALF = 128, HTB = HALF * BK * 2  , STAGE_BYTES = 8 * HTB, NXCD = 8, WGM = 8;

__host__ __device__ __forceinline__ int lds_byte(int r, int c) { const int st = (r >> 4) * 2 + (c >> 5), rr = r & 15, cc = c & 31, ob = rr * 64 + cc * 2; return st * 1024 + (ob ^ (((ob >> 9) & 1) << 5)); }
__host__ __device__ __forceinline__ void stage_rc(int b, int& R, int& C) { const int st = b / 1024, sb = b % 1024, swz = sb ^ (((sb >> 9) & 1) << 5); R = (st >> 1) * 16 + swz / 64; C = (st & 1) * 32 + (swz % 64) / 2; }
__host__ __device__ __forceinline__ int perm32(int rho) { const int n = rho >> 4, i = rho & 15; return 8 * (i >> 2) + 4 * n + (i & 3); }

struct Unit { int pm, pn, pb; };
struct Gemm { const bf16_t* A; const bf16_t* Bt; int K, lda, ldb; };

struct StaticOrder {
    int nM, nN, nwg, G, c;
    __host__ __device__ void init(int M, int N, int G_, int c_) { nM = M / BM; nN = N / BM; nwg = nM * nN; G = G_; c = c_; }
    __host__ __device__ bool next(int i, Unit& u) const {
        const long L = (long)i * G + c; if (L >= nwg) return false;
        int wgid = (int)L; { const int q = nwg / NXCD, r = nwg % NXCD, xcd = wgid % NXCD, off = wgid / NXCD; wgid = (xcd < r ? xcd * (q + 1) : r * (q + 1) + (xcd - r) * q) + off; }
        const int nig = WGM * nN, gid = wgid / nig, fm = gid * WGM, gsz = (nM - fm) < WGM ? (nM - fm) : WGM;
        u.pm = fm + ((wgid % nig) % gsz); u.pn = (wgid % nig) / gsz; u.pb = u.pn; return true;
    }
    __device__ __forceinline__ void a_ready(const Unit&) const {}
    __device__ __forceinline__ void done(const Unit&) const {}
};

__device__ __forceinline__ unsigned cvt_pk_bf16(float lo, float hi) { unsigned r; asm volatile("v_cvt_pk_bf16_f32 %0, %1, %2" : "=v"(r) : "v"(lo), "v"(hi)); return r; }
typedef float f32x2 __attribute__((ext_vector_type(2)));
__device__ __forceinline__ float sigmoidf_(float x) { return __builtin_amdgcn_rcpf(1.0f + __builtin_amdgcn_exp2f(-1.4426950408889634f * x)); }
__device__ __forceinline__ float bf_lo(unsigned w) { return __uint_as_float(w << 16); }
__device__ __forceinline__ float bf_hi(unsigned w) { return __uint_as_float(w & 0xffff0000u); }
__device__ __forceinline__ u32x4 pack8(const f32x4 a, const f32x4 b) { u32x4 w; w.x = cvt_pk_bf16(a[0], a[1]); w.y = cvt_pk_bf16(a[2], a[3]); w.z = cvt_pk_bf16(b[0], b[1]); w.w = cvt_pk_bf16(b[2], b[3]); return w; }

struct EpiSwiGLU {
    static constexpr bool PERM = true, AFTER_DRAIN = false;
    bf16_t* O; int ldc; const float* R2;
    __device__ __forceinline__ void operator()(const f32x4 (&acc)[2][2][4][2], const Unit& u, int wr, int wc, int fr, int fq) const {
        const int row0 = u.pm * BM + wr * 64 + fr, col0 = u.pn * HALF + wc * 32 + 8 * fq;
#pragma unroll
        for (int ai = 0; ai < 2; ++ai)
#pragma unroll
            for (int m = 0; m < 4; ++m) {
                bf16_t* rowp = O + (size_t)(row0 + ai * HALF + m * 16) * ldc + col0;
                const float rs = R2 ? R2[row0 + ai * HALF + m * 16] : 1.0f;
                f32x4 o[2];
#pragma unroll
                for (int n = 0; n < 2; ++n) { const f32x4 g = acc[ai][0][m][n] * rs, up = acc[ai][1][m][n] * rs;
#pragma unroll
                    for (int e = 0; e < 4; ++e) o[n][e] = g[e] * sigmoidf_(g[e]) * up[e]; }
                *(u32x4*)rowp = pack8(o[0], o[1]);
            }
    }
};
struct EpiRowSS {
    static constexpr bool PERM = true, AFTER_DRAIN = false;
    bf16_t* Y; float* SSQ;
    __device__ __forceinline__ void operator()(const f32x4 (&acc)[2][2][4][2], const Unit& u, int wr, int wc, int fr, int fq) const {
        const int row0 = u.pm * BM + wr * 64 + fr, col0 = u.pn * BM + wc * 32 + 8 * fq;
#pragma unroll
        for (int ai = 0; ai < 2; ++ai)
#pragma unroll
            for (int m = 0; m < 4; ++m) {
                const int row = row0 + ai * HALF + m * 16; float s = 0.f;
#pragma unroll
                for (int bj = 0; bj < 2; ++bj) { const f32x4 v0 = acc[ai][bj][m][0], v1 = acc[ai][bj][m][1];
                    s += (v0[0] * v0[0] + v0[1] * v0[1]) + (v0[2] * v0[2] + v0[3] * v0[3]) + (v1[0] * v1[0] + v1[1] * v1[1]) + (v1[2] * v1[2] + v1[3] * v1[3]);
                    *(u32x4*)(Y + (size_t)row * 1024 + col0 + bj * HALF) = pack8(v0, v1); }
                s += __shfl_xor(s, 16); s += __shfl_xor(s, 32);
                if (fq == 0) SSQ[(size_t)row * 16 + u.pn * 4 + wc] = s;
            }
    }
};
struct EpiQKVU {
    static constexpr bool PERM = true, AFTER_DRAIN = false;
    bf16_t* QKV; bf16_t* UX; const float* R2;
    __device__ __forceinline__ void operator()(const f32x4 (&acc)[2][2][4][2], const Unit& u, int wr, int wc, int fr, int fq) const {
        const int row0 = u.pm * BM + wr * 64 + fr, col0 = u.pn * BM + wc * 32 + 8 * fq;
#pragma unroll
        for (int ai = 0; ai < 2; ++ai)
#pragma unroll
            for (int m = 0; m < 4; ++m) {
                const int row = row0 + ai * HALF + m * 16; const float rs = R2[row];
#pragma unroll
                for (int bj = 0; bj < 2; ++bj) { const u32x4 w = pack8(acc[ai][bj][m][0] * rs, acc[ai][bj][m][1] * rs); const int col = col0 + bj * HALF;
                    if (u.pn < 6) *(u32x4*)(QKV + (size_t)row * 1536 + col) = w;
                    else { const int cu = col - 1536, g = cu >> 4, ch = cu & 15, b = row >> 13, t = row & 8191, chunk = t >> 5, s = t & 31;
                        *(u32x4*)(UX + ((size_t)(g * 1024 + b * 256 + chunk) * 640 + s * 16 + ch)) = w; } }
            }
    }
};
struct EpiS1 {
    static constexpr bool PERM = false, AFTER_DRAIN = false;
    float* XEND;
    __device__ __forceinline__ void operator()(const f32x4 (&acc)[2][2][4][2], const Unit& u, int wr, int wc, int fr, int fq) const {
        const int row0 = u.pm * BM + wr * 64 + fr, col0 = wc * 32 + 4 * fq;
#pragma unroll
        for (int ai = 0; ai < 2; ++ai)
#pragma unroll
            for (int m = 0; m < 4; ++m) {
                float* rowp = XEND + (size_t)(row0 + ai * HALF + m * 16) * 128 + col0;
#pragma unroll
                for (int n = 0; n < 2; ++n) *(f32x4*)(rowp + 16 * n) = acc[ai][0][m][n];
            }
    }
};
struct EpiS2 {
    static constexpr bool PERM = true, AFTER_DRAIN = false;
    bf16_t* YS;
    __device__ __forceinline__ void operator()(const f32x4 (&acc)[2][2][4][2], const Unit& u, int wr, int wc, int fr, int fq) const {
        const int g = u.pm >> 2, rl0 = (u.pm & 3) * BM + wr * 64 + fr, col0 = u.pn * BM + wc * 32 + 8 * fq, co0 = col0 & 15;
#pragma unroll
        for (int ai = 0; ai < 2; ++ai)
#pragma unroll
            for (int m = 0; m < 4; ++m) {
                const int rl = rl0 + ai * HALF + m * 16, b = rl >> 8, chunk = rl & 255;
#pragma unroll
                for (int bj = 0; bj < 2; ++bj) { const int col = col0 + bj * HALF, t = col >> 4;
                    f32x4 y0 = acc[ai][bj][m][0], y1 = acc[ai][bj][m][1];
#pragma unroll
                    for (int e = 0; e < 4; ++e) { const float a = y0[e], c = y1[e];
                        y0[e] = a * sigmoidf_(1.5957691216057308f * (a + 0.044715f * a * a * a));
                        y1[e] = c * sigmoidf_(1.5957691216057308f * (c + 0.044715f * c * c * c)); }
                    const size_t token = (size_t)b * 8192 + chunk * 32 + t;
                    *(u32x4*)(YS + token * 512 + g * 16 + co0) = pack8(y0, y1); }
            }
    }
};
struct EpiGLU {
    static constexpr bool PERM = true, AFTER_DRAIN = false;
    const bf16_t* YS; const float* bias; bf16_t* MIX;
    __device__ __forceinline__ void operator()(const f32x4 (&acc)[2][2][4][2], const Unit& u, int wr, int wc, int fr, int fq) const {
        const int row0 = u.pm * BM + wr * 64 + fr, col0 = u.pn * BM + wc * 32 + 8 * fq;
#pragma unroll
        for (int ai = 0; ai < 2; ++ai)
#pragma unroll
            for (int m = 0; m < 4; ++m) {
                const int row = row0 + ai * HALF + m * 16;
#pragma unroll
                for (int bj = 0; bj < 2; ++bj) { const int col = col0 + bj * HALF;
                    const u32x4 yw = *(const u32x4*)(YS + (size_t)row * 512 + col);
                    const f32x4 b0 = *(const f32x4*)(bias + col), b1 = *(const f32x4*)(bias + col + 4);
                    const f32x4 a0 = acc[ai][bj][m][0] + b0, a1 = acc[ai][bj][m][1] + b1; f32x4 o0, o1;
                    o0[0] = bf_lo(yw.x) * sigmoidf_(a0[0]); o0[1] = bf_hi(yw.x) * sigmoidf_(a0[1]); o0[2] = bf_lo(yw.y) * sigmoidf_(a0[2]); o0[3] = bf_hi(yw.y) * sigmoidf_(a0[3]);
                    o1[0] = bf_lo(yw.z) * sigmoidf_(a1[0]); o1[1] = bf_hi(yw.z) * sigmoidf_(a1[1]); o1[2] = bf_lo(yw.w) * sigmoidf_(a1[2]); o1[3] = bf_hi(yw.w) * sigmoidf_(a1[3]);
                    *(u32x4*)(MIX + (size_t)row * 1024 + 512 + col) = pack8(o0, o1); }
            }
    }
};
struct OrderS1 { int G, c;
    __device__ bool next(int i, Unit& u) const { const int L = i * G + c; if (L >= 128) return false; u.pm = L; u.pn = 0; u.pb = L >> 2; return true; }
    __device__ __forceinline__ void a_ready(const Unit&) const {}
    __device__ __forceinline__ void done(const Unit&) const {}
};
struct OrderS2 { int G, c;
    __device__ bool next(int i, Unit& u) const { const int cx = (G == 256) ? ((c & 7) * 32 + (c >> 3)) : c;
        const int L = i * G + cx; if (L >= 256) return false; const int g = L >> 3, r = L & 7; u.pm = g * 4 + (r >> 1); u.pn = r & 1; u.pb = g * 2 + u.pn; return true; }
    __device__ __forceinline__ void a_ready(const Unit&) const {}
    __device__ __forceinline__ void done(const Unit&) const {}
};

template <class Epi, class Sched, bool ALIGN_EPI = false, bool SP2 = false>
__device__ __forceinline__ void gemm_phase(PG8_LAS unsigned char* lds, const Gemm g, const Sched& S, const Epi& E) {
    const int tid = threadIdx.x, wid = __builtin_amdgcn_readfirstlane(tid >> 6), lane = tid & 63, wr = wid >> 2, wc = wid & 3, fr = lane & 15, fq = lane >> 4;
    const int K = g.K, nt = K / BK;
    unsigned voffA[2], voffB[2];
#pragma unroll
    for (int i = 0; i < 2; ++i) { int R, C; stage_rc(tid * 16 + i * 8192, R, C); const int Rb = Epi::PERM ? ((R & ~31) + perm32(R & 31)) : R;
        voffA[i] = (unsigned)(R * g.lda + C) * 2u; voffB[i] = (unsigned)(Rb * g.ldb + C) * 2u; }
    const size_t kstep = (size_t)(BK * 2);
    const size_t hstepA = (size_t)HALF * g.lda * 2, hstepB = (size_t)HALF * g.ldb * 2;
    const size_t tstepA = 2 * hstepA, tstepB = 2 * hstepB;
    const unsigned ldsw = (unsigned)wid * 1024u;
    const int aoff = lds_byte(wr * 64 + fr, fq * 8), boff = lds_byte(wc * 32 + fr, fq * 8);
#define PG8_SA(b, h) (((b) * 2 + (h)) * HTB)
#define PG8_SB(b, h) ((4 + (b) * 2 + (h)) * HTB)
#define PG8_STAGE(bufoff, gbase, voff) do { _Pragma("unroll") for (int _i = 0; _i < 2; ++_i) \
        __builtin_amdgcn_global_load_lds((const unsigned*)((const char*)(gbase) + (voff)[_i]), (PG8_LAS unsigned*)(lds + (bufoff) + ldsw + _i * 8192), 16, 0, 0); } while (0)
#define PG8_LDA(dst, b, h) do { _Pragma("unroll") for (int m = 0; m < 4; ++m) _Pragma("unroll") for (int k = 0; k < 2; ++k) dst[m][k] = *(const PG8_LAS bf16x8*)(lds + PG8_SA(b, h) + aoff + m * 2048 + k * 1024); } while (0)
#define PG8_LDB(dst, b, h) do { _Pragma("unroll") for (int n = 0; n < 2; ++n) _Pragma("unroll") for (int k = 0; k < 2; ++k) dst[n][k] = *(const PG8_LAS bf16x8*)(lds + PG8_SB(b, h) + boff + n * 2048 + k * 1024); } while (0)
#define PG8_MMA(ai, bj, At, Bt) do { __builtin_amdgcn_s_setprio(1); _Pragma("unroll") for (int m = 0; m < 4; ++m) _Pragma("unroll") for (int n = 0; n < 2; ++n) _Pragma("unroll") for (int k = 0; k < 2; ++k) \
        acc[ai][bj][m][n] = __builtin_amdgcn_mfma_f32_16x16x32_bf16(Bt[n][k], At[m][k], acc[ai][bj][m][n], 0, 0, 0); __builtin_amdgcn_s_setprio(0); } while (0)
#define PG8_WAIT_V(n) asm volatile("s_waitcnt vmcnt(" #n ")" ::: "memory")
#define PG8_WAIT_L(n) asm volatile("s_waitcnt lgkmcnt(" #n ")" ::: "memory")
#define PG8_BAR __builtin_amdgcn_s_barrier()
#define PG8_SCHED __builtin_amdgcn_sched_barrier(0)
    Unit cur, nxt; int ui = 0;
    if (!S.next(0, cur)) return;
    f32x4 acc[2][2][4][2];
#pragma unroll
    for (int a = 0; a < 2; ++a)
#pragma unroll
        for (int b = 0; b < 2; ++b)
#pragma unroll
            for (int m = 0; m < 4; ++m)
#pragma unroll
                for (int n = 0; n < 2; ++n) acc[a][b][m][n] = (f32x4){0.f, 0.f, 0.f, 0.f};
    bf16x8 At[4][2], B0[2][2], B1[2][2];
    const char* cA = (const char*)g.A + (size_t)cur.pm * tstepA; const char* cB = (const char*)g.Bt + (size_t)cur.pb * tstepB;
    S.a_ready(cur);
    if constexpr (SP2) {
        PG8_STAGE(PG8_SB(0, 0), cB, voffB); PG8_STAGE(PG8_SB(0, 1), cB + hstepB, voffB); PG8_STAGE(PG8_SA(0, 0), cA, voffA); PG8_STAGE(PG8_SA(0, 1), cA + hstepA, voffA);
        if (wr == 1) PG8_BAR;
        PG8_WAIT_V(2); PG8_BAR;
        PG8_STAGE(PG8_SB(1, 0), cB + kstep, voffB); PG8_STAGE(PG8_SA(1, 0), cA + kstep, voffA); PG8_STAGE(PG8_SB(1, 1), cB + hstepB + kstep, voffB);
        PG8_WAIT_V(6); PG8_BAR;
    } else {
        PG8_STAGE(PG8_SB(0, 0), cB, voffB); PG8_STAGE(PG8_SA(0, 0), cA, voffA); PG8_STAGE(PG8_SB(0, 1), cB + hstepB, voffB); PG8_STAGE(PG8_SA(0, 1), cA + hstepA, voffA);
        if (wr == 1) PG8_BAR;
        PG8_WAIT_V(4); PG8_BAR;
        PG8_STAGE(PG8_SB(1, 0), cB + kstep, voffB); PG8_STAGE(PG8_SA(1, 0), cA + kstep, voffA); PG8_STAGE(PG8_SB(1, 1), cB + hstepB + kstep, voffB);
        PG8_WAIT_V(6); PG8_BAR;
    }
    for (;;) {
        const bool has_next = S.next(ui + 1, nxt);
        const char* nA = has_next ? (const char*)g.A + (size_t)nxt.pm * tstepA : cA; const char* nB = has_next ? (const char*)g.Bt + (size_t)nxt.pb * tstepB : cB;
        for (int t = 0; t < nt; t += 2) {
            const bool last = (t == nt - 2);
            const char* a1 = cA + (size_t)(t + 1) * kstep;
            const char* a2 = last ? nA : cA + (size_t)(t + 2) * kstep; const char* b2 = last ? nB : cB + (size_t)(t + 2) * kstep;
            const char* a3 = a2 + kstep; const char* b3 = b2 + kstep;
            if (last && has_next) S.a_ready(nxt);
            if constexpr (SP2) {
            PG8_LDB(B0, 0, 0); PG8_LDB(B1, 0, 1); PG8_SCHED; PG8_LDA(At, 0, 0); PG8_STAGE(PG8_SA(1, 1), a1 + hstepA, voffA);
            PG8_WAIT_V(8); PG8_WAIT_L(0); PG8_BAR; PG8_MMA(0, 0, At, B0); PG8_MMA(0, 1, At, B1); PG8_BAR; PG8_SCHED;
            PG8_LDA(At, 0, 1); PG8_STAGE(PG8_SB(0, 0), b2, voffB); PG8_STAGE(PG8_SB(0, 1), b2 + hstepB, voffB); PG8_STAGE(PG8_SA(0, 0), a2, voffA);
            PG8_WAIT_V(8); PG8_WAIT_L(0); PG8_BAR; PG8_MMA(1, 0, At, B0); PG8_MMA(1, 1, At, B1); PG8_BAR; PG8_SCHED;
            PG8_LDB(B0, 1, 0); PG8_LDB(B1, 1, 1); PG8_SCHED; PG8_LDA(At, 1, 0); PG8_STAGE(PG8_SA(0, 1), a2 + hstepA, voffA);
            PG8_WAIT_V(8); PG8_WAIT_L(0); PG8_BAR; PG8_MMA(0, 0, At, B0); PG8_MMA(0, 1, At, B1); PG8_BAR; PG8_SCHED;
            PG8_LDA(At, 1, 1); PG8_STAGE(PG8_SB(1, 0), b3, voffB); PG8_STAGE(PG8_SB(1, 1), b3 + hstepB, voffB); PG8_STAGE(PG8_SA(1, 0), a3, voffA);
            PG8_WAIT_V(8); PG8_WAIT_L(0); PG8_BAR; PG8_MMA(1, 0, At, B0); PG8_MMA(1, 1, At, B1); PG8_BAR; PG8_SCHED;
            } else {
            PG8_LDB(B0, 0, 0); PG8_SCHED; PG8_LDA(At, 0, 0); PG8_STAGE(PG8_SA(1, 1), a1 + hstepA, voffA);
            PG8_WAIT_L(8); PG8_BAR; PG8_WAIT_L(0); PG8_MMA(0, 0, At, B0); PG8_BAR; PG8_SCHED;
            PG8_LDB(B1, 0, 1); PG8_STAGE(PG8_SB(0, 0), b2, voffB);
            PG8_BAR; PG8_WAIT_L(0); PG8_MMA(0, 1, At, B1); PG8_BAR;
            PG8_LDA(At, 0, 1); PG8_STAGE(PG8_SA(0, 0), a2, voffA);
            PG8_BAR; PG8_WAIT_L(0); PG8_MMA(1, 0, At, B0); PG8_BAR; PG8_SCHED;
            PG8_STAGE(PG8_SB(0, 1), b2 + hstepB, voffB);
            PG8_WAIT_V(6); PG8_BAR; PG8_MMA(1, 1, At, B1); PG8_BAR;
            PG8_LDB(B0, 1, 0); PG8_SCHED; PG8_LDA(At, 1, 0); PG8_STAGE(PG8_SA(0, 1), a2 + hstepA, voffA);
            PG8_WAIT_L(8); PG8_BAR; PG8_WAIT_L(0); PG8_MMA(0, 0, At, B0); PG8_BAR; PG8_SCHED;
            PG8_LDB(B1, 1, 1); PG8_STAGE(PG8_SB(1, 0), b3, voffB);
            PG8_BAR; PG8_WAIT_L(0); PG8_MMA(0, 1, At, B1); PG8_BAR;
            PG8_LDA(At, 1, 1); PG8_STAGE(PG8_SA(1, 0), a3, voffA);
            PG8_BAR; PG8_WAIT_L(0); PG8_MMA(1, 0, At, B0); PG8_BAR; PG8_SCHED;
            PG8_STAGE(PG8_SB(1, 1), b3 + hstepB, voffB);
            PG8_WAIT_V(6); PG8_BAR; PG8_MMA(1, 1, At, B1); PG8_BAR;
            }
        }
        if constexpr (ALIGN_EPI) { if (wr == 0) PG8_BAR; }
        if constexpr (!Epi::AFTER_DRAIN) { E(acc, cur, wr, wc, fr, fq); S.done(cur); }
        if (!has_next) break;
#pragma unroll
        for (int a = 0; a < 2; ++a)
#pragma unroll
            for (int b = 0; b < 2; ++b)
#pragma unroll
                for (int m = 0; m < 4; ++m)
#pragma unroll
                    for (int n = 0; n < 2; ++n) acc[a][b][m][n] = (f32x4){0.f, 0.f, 0.f, 0.f};
        cur = nxt; cA = nA; cB = nB; ++ui;
        if constexpr (ALIGN_EPI) { if (wr == 1) PG8_BAR; }
    }
    PG8_WAIT_V(0);
    if constexpr (!ALIGN_EPI) { if (wr == 0) PG8_BAR; }
    PG8_BAR;
    if constexpr (Epi::AFTER_DRAIN) { E.fused(acc, cur, wr, wc, fr, fq, lds, wid, lane); S.done(cur); }
#undef PG8_SA
#undef PG8_SB
#undef PG8_STAGE
#undef PG8_LDA
#undef PG8_LDB
#undef PG8_MMA
#undef PG8_WAIT_V
#undef PG8_WAIT_L
#undef PG8_BAR
#undef PG8_SCHED
}
}

namespace cg = cooperative_groups;
#define LAS __attribute__((address_space(3)))
typedef unsigned short bf16;
typedef unsigned v4u __attribute__((ext_vector_type(4)));
typedef unsigned v2u __attribute__((ext_vector_type(2)));
typedef float f32x4 __attribute__((ext_vector_type(4)));
typedef float f32x2 __attribute__((ext_vector_type(2)));

constexpr int D = 1024, BATCH = 4, SEQ = 8192, M = BATCH * SEQ, FF = 2816, NIN = 2048, NG = 32, NP = 64, NC = 16, TCH = 32, NCHUNK = SEQ / TCH;
constexpr float EPS = 1e-6f;
constexpr size_t MiB = 1u << 20;
constexpr size_t WS_WIN1 = 2 * MiB, WS_WOUT1 = 13 * MiB, WS_WMIXIN = 19 * MiB, WS_WGLU = 23 * MiB, WS_WMIXOUT = 24 * MiB, WS_WIN2 = 26 * MiB, WS_WOUT2 = 37 * MiB;
constexpr size_t WS_R1 = 44 * MiB + 64 * 1024, WS_R2 = 44 * MiB + 320 * 1024;
constexpr size_t WS_POW = 43 * MiB, WS_BBAR = 45 * MiB, WS_KTAB = 46 * MiB, WS_SSQ = 48 * MiB, WS_E = 50 * MiB, WS_KG = 66 * MiB;
constexpr size_t WS_H = 138 * MiB, WS_Y = 202 * MiB, WS_MIX = 266 * MiB, WS_ACT = 330 * MiB;
constexpr size_t WS_QKV = 330 * MiB, WS_UX = 426 * MiB, WS_YS = 466 * MiB, WS_XEND = WS_YS  , WS_END = 506 * MiB;
constexpr int KX = 640;
constexpr int LDS_BYTES = 159744;
constexpr int NPHASE = 14;

__device__ __forceinline__ unsigned f2bf(float f) { unsigned u = __builtin_bit_cast(unsigned, f); return (u + 0x7fffu + ((u >> 16) & 1u)) >> 16; }
__device__ __forceinline__ unsigned pk2(float lo, float hi) { return f2bf(lo) | (f2bf(hi) << 16); }
__device__ __forceinline__ float wave_sum(float v) {
#pragma unroll
    for (int o = 1; o < 64; o <<= 1) v += __shfl_xor(v, o);
    return v;
}
#define LDS_WAIT() asm volatile("s_waitcnt lgkmcnt(0)" ::: "memory")

template <bool GK = false> __device__ __forceinline__ void transpose_item(const float* W, int K, int N, bf16* WT, int mode, LAS float* scr, int item, int lane, const float* gk = nullptr) {
    const int nblk = N / 32, kb = item / nblk, nb = item % nblk, k0 = 64 * kb, n0 = 32 * nb;
    int dest0 = n0;
    if (mode == 1) { if (n0 < FF) dest0 = 256 * (n0 / 128) + (n0 % 128); else { const int j0 = n0 - FF; dest0 = 256 * (j0 / 128) + 128 + (j0 % 128); } }
#pragma unroll 8
    for (int i = 0; i < 32; ++i) { const int kk = 2 * i + (lane >> 5); scr[kk * 33 + (lane & 31)] = __builtin_nontemporal_load(W + (size_t)(k0 + kk) * N + n0 + (lane & 31)); }
    LDS_WAIT(); asm volatile("" ::: "memory");
    const int c = lane & 7;
    f32x4 ga = (f32x4){1.f, 1.f, 1.f, 1.f}, gb = ga;
    if (GK) { ga = *(const f32x4*)(gk + k0 + 8 * c); gb = *(const f32x4*)(gk + k0 + 8 * c + 4); }
#pragma unroll
    for (int j = 0; j < 4; ++j) { const int n = (lane >> 3) + 8 * j; const LAS float* s = scr + (8 * c) * 33 + n;
        v4u o; o.x = pk2(s[0 * 33] * ga.x, s[1 * 33] * ga.y); o.y = pk2(s[2 * 33] * ga.z, s[3 * 33] * ga.w); o.z = pk2(s[4 * 33] * gb.x, s[5 * 33] * gb.y); o.w = pk2(s[6 * 33] * gb.z, s[7 * 33] * gb.w);
        *(v4u*)(WT + (size_t)(dest0 + n) * K + k0 + 8 * c) = o; }
    LDS_WAIT(); asm volatile("" ::: "memory");
}
template <int NR> __device__ __forceinline__ void norm_rows_to_bf16(const float* x, float* r1out, bf16* H, int m0, int mstride, int lane) {
    f32x4 v[NR][4];
#pragma unroll
    for (int r = 0; r < NR; ++r) { const size_t m = (size_t)m0 + (size_t)r * mstride;
#pragma unroll
        for (int j = 0; j < 4; ++j) v[r][j] = __builtin_nontemporal_load((const f32x4*)(x + m * D) + lane + 64 * j); }
#pragma unroll
    for (int r = 0; r < NR; ++r) { const size_t m = (size_t)m0 + (size_t)r * mstride; float s = 0.f;
#pragma unroll
        for (int j = 0; j < 4; ++j) s += (v[r][j].x * v[r][j].x + v[r][j].y * v[r][j].y) + (v[r][j].z * v[r][j].z + v[r][j].w * v[r][j].w);
        const float rr = 1.0f / sqrtf(wave_sum(s) * (1.f / D) + EPS);
        if (lane == 0) r1out[m] = rr;
        unsigned long long* o8 = (unsigned long long*)(H + m * D) + lane;
#pragma unroll
        for (int j = 0; j < 4; ++j) o8[64 * j] = (unsigned long long)pk2(v[r][j].x, v[r][j].y) | ((unsigned long long)pk2(v[r][j].z, v[r][j].w) << 32);
    }
}
__device__ __forceinline__ f32x2 cpow_n(float dt, float are, float aim, int n) {
    double th = (double)n * ((double)dt * (double)aim);
    th -= 6.283185307179586476925 * rint(th * 0.15915494309189533577);
    const float sn = sinf((float)th), cs = cosf((float)th);
    const float mag = expf((float)n * dt * are);
    return (f32x2){mag * cs, mag * sn};
}
__device__ __forceinline__ f32x2 zoh_factor(float dt, float are, float aim) {
    const float lr = dt * are, li = dt * aim;
    const float sh = sinf(0.5f * li), cm1 = -2.0f * sh * sh, sn = sinf(li), cs = 1.0f + cm1;
    const float em1 = expm1f(lr), ex = em1 + 1.0f;
    const float xr = em1 * cs + cm1, xi = ex * sn;
    const float den = 1.0f / (are * are + aim * aim);
    return (f32x2){(xr * are + xi * aim) * den, (xi * are - xr * aim) * den};
}

template <int NR, bool XIN_BF, bool XOUT_BF, bool FOLD = false> __device__ __forceinline__ void row_pass_rows(const void* xin, const bf16* y, const float* ssq, const float* gpost, float scale, void* xout, const float* gnext, bf16* hout, int m0, int mstride, int lane) {
    f32x4 xv[NR][4]; v2u yw[NR][4]; float ss[NR];
#pragma unroll
    for (int r = 0; r < NR; ++r) { const size_t m = (size_t)m0 + (size_t)r * mstride; ss[r] = ssq[m * 16 + (lane & 15)];
#pragma unroll
        for (int j = 0; j < 4; ++j) {
            if (XIN_BF) { const v2u w = __builtin_nontemporal_load((const v2u*)((const bf16*)xin + m * D) + lane + 64 * j); xv[r][j] = (f32x4){__uint_as_float(w.x << 16), __uint_as_float(w.x & 0xffff0000u), __uint_as_float(w.y << 16), __uint_as_float(w.y & 0xffff0000u)}; }
            else xv[r][j] = __builtin_nontemporal_load((const f32x4*)((const float*)xin + m * D) + lane + 64 * j);
            yw[r][j] = __builtin_nontemporal_load((const v2u*)(y + m * D) + lane + 64 * j); } }
    f32x4 gp[4];
#pragma unroll
    for (int j = 0; j < 4; ++j) gp[j] = ((const f32x4*)gpost)[lane + 64 * j];
#pragma unroll
    for (int r = 0; r < NR; ++r) { const size_t m = (size_t)m0 + (size_t)r * mstride;
        float s1 = ss[r]; s1 += __shfl_xor(s1, 1); s1 += __shfl_xor(s1, 2); s1 += __shfl_xor(s1, 4); s1 += __shfl_xor(s1, 8);
        const float rr = scale / sqrtf(s1 * (1.f / D) + EPS); float s2 = 0.f;
#pragma unroll
        for (int j = 0; j < 4; ++j) { f32x4 o; const f32x4 x4 = xv[r][j]; const v2u w = yw[r][j];
            o.x = x4.x + __uint_as_float(w.x << 16) * rr * gp[j].x; o.y = x4.y + __uint_as_float(w.x & 0xffff0000u) * rr * gp[j].y;
            o.z = x4.z + __uint_as_float(w.y << 16) * rr * gp[j].z; o.w = x4.w + __uint_as_float(w.y & 0xffff0000u) * rr * gp[j].w;
            xv[r][j] = o; s2 += (o.x * o.x + o.y * o.y) + (o.z * o.z + o.w * o.w);
            if (XOUT_BF) { v2u ow; ow.x = pk2(o.x, o.y); ow.y = pk2(o.z, o.w); if (FOLD) ((v2u*)((bf16*)xout + m * D))[lane + 64 * j] = ow;   else __builtin_nontemporal_store(ow, (v2u*)((bf16*)xout + m * D) + lane + 64 * j); }
            else __builtin_nontemporal_store(o, (f32x4*)((float*)xout + m * D) + lane + 64 * j); }
        if (FOLD) { const float r2 = 1.0f / sqrtf(wave_sum(s2) * (1.f / D) + EPS); if (lane == 0) ((float*)hout)[m] = r2; }
        else if (gnext) {
            const float r2 = 1.0f / sqrtf(wave_sum(s2) * (1.f / D) + EPS);
            unsigned long long* o8 = (unsigned long long*)(hout + m * D) + lane;
#pragma unroll
            for (int j = 0; j < 4; ++j) { const f32x4 gg = ((const f32x4*)gnext)[lane + 64 * j]; const f32x4 v = xv[r][j];
                o8[64 * j] = (unsigned long long)pk2(v.x * r2 * gg.x, v.y * r2 * gg.y) | ((unsigned long long)pk2(v.z * r2 * gg.z, v.w * r2 * gg.w) << 32); }
        }
    }
}

typedef short bf16x8_t __attribute__((ext_vector_type(8)));
typedef short s16x4_t __attribute__((ext_vector_type(4)));
constexpr int AT_UTOK = 512;
constexpr int AT_OPITCH = 72;
constexpr int AT_O_OFF = 0, AT_ML_OFF = AT_UTOK * AT_OPITCH * 2, AT_V_OFF = AT_ML_OFF + AT_UTOK * 8, AT_VROW = 144, AT_VWAVE = 32 * AT_VROW;
constexpr int AT_K_OFF = AT_V_OFF + 8 * AT_VWAVE;
static_assert(AT_K_OFF + 8 * AT_VWAVE <= 158720, "attention LDS map");
__device__ __forceinline__ s16x4_t tr_read16(LAS unsigned char* p) { return __builtin_bit_cast(s16x4_t, __builtin_amdgcn_ds_read_tr16_b64_v4i16((LAS s16x4_t*)p)); }
__device__ __forceinline__ unsigned cvtpk(float lo, float hi) { typedef float f2 __attribute__((ext_vector_type(2))); typedef __bf16 b2 __attribute__((ext_vector_type(2))); f2 v = {lo, hi}; b2 b = __builtin_convertvector(v, b2); return __builtin_bit_cast(unsigned, b); }

__device__ __forceinline__ float xmax16(float v) { auto r = __builtin_amdgcn_permlane16_swap(__float_as_uint(v), __float_as_uint(v), false, false); return fmaxf(__uint_as_float(r[0]), __uint_as_float(r[1])); }
__device__ __forceinline__ float xmax32(float v) { auto r = __builtin_amdgcn_permlane32_swap(__float_as_uint(v), __float_as_uint(v), false, false); return fmaxf(__uint_as_float(r[0]), __uint_as_float(r[1])); }
__device__ __forceinline__ float xadd16(float v) { auto r = __builtin_amdgcn_permlane16_swap(__float_as_uint(v), __float_as_uint(v), false, false); return __uint_as_float(r[0]) + __uint_as_float(r[1]); }
__device__ __forceinline__ float xadd32(float v) { auto r = __builtin_amdgcn_permlane32_swap(__float_as_uint(v), __float_as_uint(v), false, false); return __uint_as_float(r[0]) + __uint_as_float(r[1]); }
constexpr float AT_MFLOOR = -1.0e4f;
template <int BR, int NU, int PF> __device__ __forceinline__ void attn_jobN(const bf16* QKVb, int h, int Tq0, LAS unsigned char* vst, f32x4 (&o)[NU][4], float (&m_out)[NU], float (&l_out)[NU], int lane) {
    constexpr int DIL = BR == 0 ? 1 : (BR == 1 ? 4 : 16), SMIN = BR == 0 ? 0 : 33, NSTEP = (128 - SMIN + 16 * NU + 31) / 32;
    const int fr = lane & 15, fq = lane >> 4;
    const float slope2 = exp2f(-(float)(h + 1)) * 1.4426950408889634f * (float)DIL;
    const char* qb = (const char*)QKVb;
    bf16x8_t qf[NU][2];
#pragma unroll
    for (int u = 0; u < NU; ++u) { const unsigned qoff = (unsigned)(Tq0 + DIL * (16 * u + fr)) * 3072u + (unsigned)(h * 128 + 16 * fq);
#pragma unroll
      for (int ks = 0; ks < 2; ++ks) { const v4u w = *(const v4u*)(qb + (qoff + 64u * ks)); const float c = 0.18033688011112042f; v4u sv;
          sv.x = cvtpk(c * __uint_as_float(w.x << 16), c * __uint_as_float(w.x & 0xffff0000u)); sv.y = cvtpk(c * __uint_as_float(w.y << 16), c * __uint_as_float(w.y & 0xffff0000u));
          sv.z = cvtpk(c * __uint_as_float(w.z << 16), c * __uint_as_float(w.z & 0xffff0000u)); sv.w = cvtpk(c * __uint_as_float(w.w << 16), c * __uint_as_float(w.w & 0xffff0000u));
          qf[u][ks] = __builtin_bit_cast(bf16x8_t, sv); } }
    const int Tk0 = Tq0 - 128 * DIL;
    const int sbase = 128 + fr - 4 * fq;
    float A0[8];
#pragma unroll
    for (int e = 0; e < 8; ++e) { const int sr = sbase - (e & 3); float lg = 0.f; if (BR <= 1 && (sr & 3) == 0) lg = 1.0f; if (BR == 0 && (sr & 15) == 0) lg = 1.5849625007211562f;
        A0[e] = lg - slope2 * (float)(sbase - 16 * (e >> 2) - (e & 3)); }
    const int kmin = Tk0 < 0 ? (-Tk0 + DIL - 1) / DIL : 0;
    float m[NU], l[NU];
#pragma unroll
    for (int u = 0; u < NU; ++u) { m[u] = AT_MFLOOR; l[u] = 0.f;
#pragma unroll
        for (int db = 0; db < 4; ++db) o[u][db] = (f32x4){0.f, 0.f, 0.f, 0.f}; }
    const unsigned kvcol = (unsigned)(1024 + h * 128 + 16 * (lane & 7));
    LAS unsigned char* vwr = vst + (lane >> 3) * AT_VROW + (lane & 7) * 16;
    LAS unsigned char* vrd = vst + (4 * fq + (fr >> 2)) * AT_VROW + 8 * (fr & 3);
    LAS unsigned char* kwr = vwr + (AT_K_OFF - AT_V_OFF);
    LAS unsigned char* krd = vst + (AT_K_OFF - AT_V_OFF) + fr * AT_VROW + 16 * fq;
    v4u kreg[PF][4], vreg[PF][4];
#define AT_CLAMP(t) ((t) < 0 ? 0 : ((t) > SEQ - 1 ? SEQ - 1 : (t)))
#define AT_LOAD(step, BUF) do { \
        _Pragma("unroll") for (int i = 0; i < 4; ++i) { const int tv = Tk0 + DIL * (32 * (step) + (lane >> 3) + 8 * i); const unsigned ro = (unsigned)AT_CLAMP(tv) * 3072u + kvcol; \
            kreg[BUF][i] = *(const v4u*)(qb + ro); vreg[BUF][i] = *(const v4u*)(qb + (ro + 1024u)); } \
    } while (0)
    AT_LOAD(NSTEP - 1, 0);
    if (PF == 2) AT_LOAD(NSTEP - 2, PF - 1);
#pragma unroll (PF == 2 ? NSTEP : 1)
    for (int step = NSTEP - 1; step >= 0; --step) {
        const int buf = PF == 2 ? ((NSTEP - 1 - step) & 1) : 0;
#pragma unroll
        for (int i = 0; i < 4; ++i) { *(LAS v4u*)(kwr + 8 * i * AT_VROW) = kreg[buf][i]; *(LAS v4u*)(vwr + 8 * i * AT_VROW) = vreg[buf][i]; }
        const bf16x8_t kf0 = *(LAS bf16x8_t*)(krd), kf1 = *(LAS bf16x8_t*)(krd + 64), kf2 = *(LAS bf16x8_t*)(krd + 16 * AT_VROW), kf3 = *(LAS bf16x8_t*)(krd + 16 * AT_VROW + 64);
        const float bst = slope2 * (float)(32 * step);
        const bool edge = (32 * step < 16 * NU) || (32 * step + 31 > 128 - SMIN) || (32 * step < kmin);
        bf16x8_t pf[NU];
#pragma unroll
        for (int u = 0; u < NU; ++u) {
            const float c0 = bst - m[u] - slope2 * (float)(16 * u);
            f32x4 sA = (f32x4){c0, c0, c0, c0}, sB = sA;
            sA = __builtin_amdgcn_mfma_f32_16x16x32_bf16(kf0, qf[u][0], sA, 0, 0, 0); sA = __builtin_amdgcn_mfma_f32_16x16x32_bf16(kf1, qf[u][1], sA, 0, 0, 0);
            sB = __builtin_amdgcn_mfma_f32_16x16x32_bf16(kf2, qf[u][0], sB, 0, 0, 0); sB = __builtin_amdgcn_mfma_f32_16x16x32_bf16(kf3, qf[u][1], sB, 0, 0, 0);
            float sc[8];
#pragma unroll
            for (int e = 0; e < 8; ++e) sc[e] = ((e < 4) ? sA[e & 3] : sB[e & 3]) + A0[e];
            if (edge) {
                const int klo = (fr + 16 * u) > kmin ? (fr + 16 * u) : kmin, khi = 128 + 16 * u + fr - SMIN;
#pragma unroll
                for (int e = 0; e < 8; ++e) { const int kap = 32 * step + 16 * (e >> 2) + 4 * fq + (e & 3); if (kap < klo || kap > khi) sc[e] = -INFINITY; }
            }
            float mx = fmaxf(fmaxf(fmaxf(sc[0], sc[1]), fmaxf(sc[2], sc[3])), fmaxf(fmaxf(sc[4], sc[5]), fmaxf(sc[6], sc[7])));
            mx = xmax16(mx); mx = xmax32(mx);
            if (__builtin_amdgcn_ballot_w64(mx > 0.f) != 0ull) {
                const float dl = fmaxf(mx, 0.f), corr = __builtin_amdgcn_exp2f(-dl);
                m[u] += dl; l[u] *= corr;
#pragma unroll
                for (int e = 0; e < 8; ++e) sc[e] -= dl;
#pragma unroll
                for (int db = 0; db < 4; ++db) o[u][db] = o[u][db] * corr;
            }
            float ps = 0.f;
#pragma unroll
            for (int e = 0; e < 8; ++e) { sc[e] = __builtin_amdgcn_exp2f(sc[e]); ps += sc[e]; }
            l[u] += ps;
            v4u pw; pw.x = cvtpk(sc[0], sc[1]); pw.y = cvtpk(sc[2], sc[3]); pw.z = cvtpk(sc[4], sc[5]); pw.w = cvtpk(sc[6], sc[7]);
            pf[u] = __builtin_bit_cast(bf16x8_t, pw);
            if (NU > 2) __builtin_amdgcn_sched_barrier(0);
        }
        if (NU > 2) __builtin_amdgcn_sched_barrier(0);
        if (step >= PF) { if (buf == 0) AT_LOAD(step - PF, 0); else AT_LOAD(step - PF, PF - 1); }
#pragma unroll
        for (int db = 0; db < 4; ++db) {
            if (NU > 2) __builtin_amdgcn_sched_barrier(0);
            const s16x4_t va = tr_read16(vrd + db * 32), vb = tr_read16(vrd + 16 * AT_VROW + db * 32);
            const bf16x8_t vf = (bf16x8_t){va[0], va[1], va[2], va[3], vb[0], vb[1], vb[2], vb[3]};
#pragma unroll
            for (int u = 0; u < NU; ++u) o[u][db] = __builtin_amdgcn_mfma_f32_16x16x32_bf16(vf, pf[u], o[u][db], 0, 0, 0);
        }
        if (NU > 2 || PF == 2) __builtin_amdgcn_sched_barrier(0);
    }
#undef AT_LOAD
#undef AT_CLAMP
#pragma unroll
    for (int u = 0; u < NU; ++u) { float lv = l[u]; lv = xadd16(lv); lv = xadd32(lv); m_out[u] = m[u]; l_out[u] = lv; }
}
template <int MODE> __device__ __forceinline__ void attn_merge(LAS unsigned char* lds, int lq, f32x4 (&o)[4], float m, float l, bf16* orow  , int lane) {
    const int fq = lane >> 4;
    LAS bf16* Ol = (LAS bf16*)(lds + AT_O_OFF) + lq * AT_OPITCH + 4 * fq;
    LAS float* Ml = (LAS float*)(lds + AT_ML_OFF); LAS float* Ll = Ml + AT_UTOK;
    if (MODE != 0) {
        const float mo = Ml[lq], lo = Ll[lq]; const float mn = fmaxf(mo, m), a = __builtin_amdgcn_exp2f(mo - mn), b = __builtin_amdgcn_exp2f(m - mn);
#pragma unroll
        for (int db = 0; db < 4; ++db) { const v2u w = *(LAS v2u*)(Ol + 16 * db);
            const f32x4 oo = (f32x4){__uint_as_float(w.x << 16), __uint_as_float(w.x & 0xffff0000u), __uint_as_float(w.y << 16), __uint_as_float(w.y & 0xffff0000u)};
            o[db] = oo * a + o[db] * b; }
        l = lo * a + l * b; m = mn;
    }
    if (MODE != 2) {
#pragma unroll
        for (int db = 0; db < 4; ++db) { v2u w; w.x = cvtpk(o[db][0], o[db][1]); w.y = cvtpk(o[db][2], o[db][3]); *(LAS v2u*)(Ol + 16 * db) = w; }
        if (fq == 0) { Ml[lq] = m; Ll[lq] = l; }
    } else {
        const float rl = 1.0f / l;
#pragma unroll
        for (int db = 0; db < 4; ++db) { v2u w; w.x = cvtpk(o[db][0] * rl, o[db][1] * rl); w.y = cvtpk(o[db][2] * rl, o[db][3] * rl); *(v2u*)(orow + 16 * db + 4 * fq) = w; }
    }
}
__device__ __forceinline__ void attn_unit(LAS unsigned char* lds, const bf16* QKV, bf16* MIX, int unit, int wave, int lane) {
    const int b = unit >> 7, h = (unit >> 4) & 7, U0 = (unit & 15) * AT_UTOK, fr = lane & 15;
    const bf16* QKVb = QKV + (size_t)b * SEQ * 1536; bf16* MIXb = MIX + (size_t)b * SEQ * 1024 + h * 64;
    LAS unsigned char* vst = lds + AT_V_OFF + wave * AT_VWAVE;
#pragma unroll 1
    for (int j = wave; j < 16; j += 8) { f32x4 o[2][4]; float m[2], l[2]; const int q0 = 32 * j;
      int ln = lane; asm volatile("" : "+v"(ln));
      attn_jobN<0, 2, 2>(QKVb, h, U0 + q0, vst, o, m, l, ln);
      if (j == wave) __syncthreads();
#pragma unroll
      for (int u = 0; u < 2; ++u) attn_merge<0>(lds, q0 + 16 * u + fr, o[u], m[u], l[u], nullptr, lane); }
#pragma unroll 1
    for (int j = wave; j < 16; j += 8) { f32x4 o[2][4]; float m[2], l[2]; const int q0 = (j & 3) + 128 * (j >> 2);
      int ln = lane; asm volatile("" : "+v"(ln));
      attn_jobN<1, 2, 2>(QKVb, h, U0 + q0, vst, o, m, l, ln);
      if (j == wave) __syncthreads();
#pragma unroll
      for (int u = 0; u < 2; ++u) attn_merge<1>(lds, q0 + 4 * (16 * u + fr), o[u], m[u], l[u], nullptr, lane); }
#pragma unroll 1
    for (int j = wave; j < 16; j += 8) { f32x4 o[2][4]; float m[2], l[2];
      int ln = lane; asm volatile("" : "+v"(ln));
      attn_jobN<2, 2, 2>(QKVb, h, U0 + j, vst, o, m, l, ln);
      if (j == wave) __syncthreads();
#pragma unroll
      for (int u = 0; u < 2; ++u) { const int lq = j + 16 * (16 * u + fr); attn_merge<2>(lds, lq, o[u], m[u], l[u], MIXb + (size_t)(U0 + lq) * 1024, lane); } }
}

#define RLX_AGENT __ATOMIC_RELAXED, __HIP_MEMORY_SCOPE_AGENT
#define XB_TMO      128
#define XB_XCNT(j)  (256  + 64 * (j))
#define XB_XSUB(j)  (1280 + 64 * (j))
#define XB_XGEN(j)  (2304 + 64 * (j))
#define XB_TOP      3328
#define XB_TOPGEN   3392
#define XCD_BAR_WORDS 3456
#define XB_SPIN_CAP (1u << 18)

__device__ __forceinline__ unsigned xb_ld(unsigned* p)              { return __hip_atomic_load(p, __ATOMIC_RELAXED, __HIP_MEMORY_SCOPE_AGENT); }
__device__ __forceinline__ unsigned xb_add(unsigned* p, unsigned v) { return __hip_atomic_fetch_add(p, v, __ATOMIC_RELAXED, __HIP_MEMORY_SCOPE_AGENT); }
__device__ __forceinline__ unsigned xb_xcc_id() { return (unsigned)__builtin_amdgcn_s_getreg((3 << 11) | 20) & 0xFu; }
#define XB_SPIN(cond, bar) do { unsigned _sp = 0; while (cond) { __builtin_amdgcn_s_sleep(1); \
    if ((++_sp & 255u) == 0u) { if (xb_ld(&(bar)[XB_TMO])) break; if (_sp > XB_SPIN_CAP) { atomicAdd(&(bar)[XB_TMO], 1u); break; } } } } while (0)

struct XcdBarrier {
    unsigned* bar; unsigned x;
    volatile LAS unsigned* st;
};

__device__ __forceinline__ XcdBarrier xcd_barrier_post(unsigned* bar, volatile LAS unsigned* st) {
    XcdBarrier b; b.bar = bar; b.x = xb_xcc_id(); b.st = st;
    if (threadIdx.x == 0) (void)xb_add(&bar[XB_XCNT(b.x)], 1u);
    return b;
}
__device__ __forceinline__ void xcd_barrier_complete(unsigned* bar, unsigned x, unsigned& nloc, unsigned& nx) {
    const unsigned G = gridDim.x * gridDim.y * gridDim.z;
    unsigned sum, cnt, mine, sp = 0u;
    for (;;) {
        sum = 0u; cnt = 0u; mine = 0u;
#pragma unroll
        for (unsigned j = 0; j < 16; ++j) { const unsigned c = xb_ld(&bar[XB_XCNT(j)]); sum += c; cnt += (c > 0u) ? 1u : 0u; mine = (j == x) ? c : mine; }
        if (sum == G) break;
        __builtin_amdgcn_s_sleep(1);
        if ((++sp & 255u) == 0u) { if (xb_ld(&bar[XB_TMO])) break; if (sp > XB_SPIN_CAP) { atomicAdd(&bar[XB_TMO], 1u); break; } }
    }
    nloc = mine > 0u ? mine : 1u; nx = cnt > 0u ? cnt : 1u;
}

__device__ __forceinline__ void xcd_barrier(const XcdBarrier& b) {
    asm volatile("s_waitcnt vmcnt(0)" ::: "memory");
    __syncthreads();
    if (threadIdx.x == 0) {
        unsigned* bar = b.bar;
        __builtin_amdgcn_s_waitcnt(0);
        unsigned nloc = b.st[0], nx = b.st[1];
        if (nloc == 0u) { xcd_barrier_complete(bar, b.x, nloc, nx); b.st[0] = nloc; b.st[1] = nx; }
        const unsigned old = xb_add(&bar[XB_XSUB(b.x)], 1u);
        const unsigned gen = old / nloc;
        if (old + 1u == (gen + 1u) * nloc) {
            __builtin_amdgcn_fence(__ATOMIC_RELEASE, "agent");
            asm volatile("s_waitcnt vmcnt(0)" ::: "memory");
            const unsigned og = xb_add(&bar[XB_TOP], 1u);
            const unsigned tg = og / nx;
            if (og + 1u == (tg + 1u) * nx) xb_add(&bar[XB_TOPGEN], 1u);
            else XB_SPIN(xb_ld(&bar[XB_TOPGEN]) == tg, bar);
            __builtin_amdgcn_fence(__ATOMIC_ACQUIRE, "agent");
            xb_add(&bar[XB_XGEN(b.x)], 1u);
            asm volatile("s_waitcnt vmcnt(0)" ::: "memory");
        } else {
            XB_SPIN(xb_ld(&bar[XB_XGEN(b.x)]) == gen, bar);
            __builtin_amdgcn_fence(__ATOMIC_ACQUIRE, "agent");
            asm volatile("s_waitcnt vmcnt(0)" ::: "memory");
        }
    }
    __syncthreads();
}
struct Args { const float* in[23]; float* out; unsigned char* ws; int ph_lo, ph_hi; };


#define WSP(T, off) ((T*)(ws + (off)))
__device__ __forceinline__ void ph_prologue(LAS unsigned char* lds, const Args& a, unsigned char* ws, int G, int bx, int tid, int lane, int wave, int parts = 7) {
    const int gw = bx * 8 + wave, NGW = G * 8;
    const float *a_re = a.in[7], *a_im = a.in[8], *log_dt = a.in[9], *b_re = a.in[10], *b_im = a.in[11], *c_re = a.in[12], *c_im = a.in[13];
    f32x2* POW = WSP(f32x2, WS_POW); f32x2* BBAR = WSP(f32x2, WS_BBAR); float* KTAB = WSP(float, WS_KTAB);
    if (parts & 1)
    for (int unit = bx; unit < 128; unit += G) {
        const int g = unit >> 2, tb = unit & 3;
        LAS f32x2* powL = (LAS f32x2*)lds;
        LAS f32x2* bbL = (LAS f32x2*)(lds + 4096);
        __syncthreads();
        LAS f32x2* cL = (LAS f32x2*)(lds + 12288);
#pragma unroll
        for (int e = 0; e < 2; ++e) { const int idx = tid + 512 * e; cL[idx] = (f32x2){c_re[(size_t)g * 1024 + idx], c_im[(size_t)g * 1024 + idx]}; }
        const float dt = expf(log_dt[g]);
        { const int p = tid >> 3, j = tid & 7; const float are = a_re[g * 64 + p], aim = a_im[g * 64 + p];
          const f32x2 pw = cpow_n(dt, are, aim, 8 * tb + j); powL[p * 8 + j] = pw; POW[(size_t)(g * 64 + p) * 65 + 8 * tb + j] = pw;
          if (tb == 3 && j == 0) POW[(size_t)(g * 64 + p) * 65 + TCH] = cpow_n(dt, are, aim, TCH);
          const f32x2 z = zoh_factor(dt, are, aim);
#pragma unroll
          for (int e = 0; e < 2; ++e) { const int ci = 2 * j + e; const float br = b_re[(size_t)(g * 64 + p) * 16 + ci], bi = b_im[(size_t)(g * 64 + p) * 16 + ci];
              const f32x2 bb = (f32x2){z.x * br - z.y * bi, z.x * bi + z.y * br}; bbL[p * 16 + ci] = bb; if (tb == 0) BBAR[(size_t)(g * 64 + p) * 16 + ci] = bb; } }
        __syncthreads();
        { const int cc = tid & 255, co = cc >> 4, ci = cc & 15;
          for (int jj = 0; jj < 4; ++jj) { const int j = (tid >> 8) + 2 * jj; float acc = 0.f;
#pragma unroll 8
              for (int p = 0; p < 64; ++p) { const f32x2 cv = cL[co * 64 + p];
                  const f32x2 pw = powL[p * 8 + j], bb = bbL[p * 16 + ci];
                  const float tr = pw.x * bb.x - pw.y * bb.y, ti = pw.x * bb.y + pw.y * bb.x;
                  acc += cv.x * tr - cv.y * ti; }
              if (8 * tb + j == 0 && co == ci) acc += a.in[14][g * 16 + co];
              KTAB[((size_t)(g * TCH + 8 * tb + j) * 16 + co) * 16 + ci] = acc; } }
        __syncthreads();
    }
    LAS float* scr = (LAS float*)(lds + wave * 16384);
    constexpr int I_IN = (D / 64) * (2 * FF / 32), I_OUT = (FF / 64) * (D / 32), I_MI = (D / 64) * (NIN / 32), I_GLU = (512 / 64) * (512 / 32), I_MO = (D / 64) * (D / 32);
    constexpr int NITEMS = 2 * I_IN + 2 * I_OUT + I_MI + I_GLU + I_MO;
    const bool bal = (G == 256); const int nvid = bal ? (bx < 128 ? 2 : 5) : 1, V = bal ? 7168 : NGW, vid0 = bal ? (bx < 128 ? gw * 2 : 2048 + (gw - 1024) * 5) : gw;
    const int nitems0 = bal ? (I_IN + I_OUT + I_MI) : NITEMS;
    if (parts & 2)
    for (int kv = 0; kv < nvid; ++kv)
    for (int it = vid0 + kv; it < nitems0; it += V) {
        int r = it;
        if (r < I_IN) { transpose_item<true>(a.in[2], D, 2 * FF, WSP(bf16, WS_WIN1), 1, scr, r, lane, a.in[1]); continue; } r -= I_IN;
        if (r < I_OUT) { transpose_item(a.in[3], FF, D, WSP(bf16, WS_WOUT1), 0, scr, r, lane); continue; } r -= I_OUT;
        if (r < I_MI) { transpose_item<true>(a.in[6], D, NIN, WSP(bf16, WS_WMIXIN), 0, scr, r, lane, a.in[5]); continue; } r -= I_MI;
        if (r < I_GLU) { transpose_item(a.in[15], 512, 512, WSP(bf16, WS_WGLU), 0, scr, r, lane); continue; } r -= I_GLU;
        if (r < I_MO) { transpose_item(a.in[17], D, D, WSP(bf16, WS_WMIXOUT), 0, scr, r, lane); continue; } r -= I_MO;
        if (r < I_IN) { transpose_item<true>(a.in[20], D, 2 * FF, WSP(bf16, WS_WIN2), 1, scr, r, lane, a.in[19]); continue; } r -= I_IN;
        transpose_item(a.in[21], FF, D, WSP(bf16, WS_WOUT2), 0, scr, r, lane);
    }
    const float* x = a.in[0]; float* g1 = WSP(float, WS_R1); bf16* H = WSP(bf16, WS_H);
    if (parts & 4)
    for (int kv = 0; kv < nvid; ++kv) { int m = vid0 + kv;
      for (; m + 3 * V < M; m += 4 * V) norm_rows_to_bf16<4>(x, g1, H, m, V, lane);
      for (; m < M; m += V) norm_rows_to_bf16<1>(x, g1, H, m, V, lane); }
}
__device__ __forceinline__ void ph_late_weights(LAS unsigned char* lds, const Args& a, unsigned char* ws, int w0, int nw, int wave, int lane) {
    LAS float* scr = (LAS float*)(lds + wave * 16384);
    constexpr int I_IN = (D / 64) * (2 * FF / 32), I_OUT = (FF / 64) * (D / 32), I_GLU = (512 / 64) * (512 / 32), I_MO = (D / 64) * (D / 32);
    for (int it = w0; it < I_GLU + I_MO + I_IN + I_OUT; it += nw) {
        int r = it;
        if (r < I_GLU) { transpose_item(a.in[15], 512, 512, WSP(bf16, WS_WGLU), 0, scr, r, lane); continue; } r -= I_GLU;
        if (r < I_MO) { transpose_item(a.in[17], D, D, WSP(bf16, WS_WMIXOUT), 0, scr, r, lane); continue; } r -= I_MO;
        if (r < I_IN) { transpose_item<true>(a.in[20], D, 2 * FF, WSP(bf16, WS_WIN2), 1, scr, r, lane, a.in[19]); continue; } r -= I_IN;
        transpose_item(a.in[21], FF, D, WSP(bf16, WS_WOUT2), 0, scr, r, lane);
    }
}
__device__ __forceinline__ void ph_ffn_in(LAS unsigned char* lds, unsigned char* ws, const bf16* A, size_t w_off, const float* R2, int G, int bx) {
    pg8::Gemm g{A, WSP(bf16, w_off), D, D, D}; pg8::StaticOrder S; S.init(M, 2 * FF, G, bx);
    pg8::EpiSwiGLU Ep{WSP(bf16, WS_ACT), FF, R2};
    pg8::gemm_phase<pg8::EpiSwiGLU, pg8::StaticOrder, true, true>(lds, g, S, Ep);
}
__device__ __forceinline__ void ph_rowss(LAS unsigned char* lds, unsigned char* ws, size_t a_off, size_t w_off, int K, int G, int bx) {
    pg8::Gemm g{WSP(bf16, a_off), WSP(bf16, w_off), K, K, K}; pg8::StaticOrder S; S.init(M, D, G, bx);
    pg8::EpiRowSS Ep{WSP(bf16, WS_Y), WSP(float, WS_SSQ)};
    pg8::gemm_phase<pg8::EpiRowSS, pg8::StaticOrder, true, true>(lds, g, S, Ep);
}
template <bool XIN_BF, bool XOUT_BF, bool FOLD = false> __device__ __forceinline__ void ph_rowpass(unsigned char* ws, const void* xin, const float* gpost, float scale, void* out, const float* gnext, int gw, int NGW, int lane) {
    const bf16* Y = WSP(bf16, WS_Y); const float* SSQ = WSP(float, WS_SSQ); bf16* H = FOLD ? (bf16*)WSP(float, WS_R2) : WSP(bf16, WS_H);
    int m = gw;
    for (; m + 3 * NGW < M; m += 4 * NGW) row_pass_rows<4, XIN_BF, XOUT_BF, FOLD>(xin, Y, SSQ, gpost, scale, out, gnext, H, m, NGW, lane);
    for (; m < M; m += NGW) row_pass_rows<1, XIN_BF, XOUT_BF, FOLD>(xin, Y, SSQ, gpost, scale, out, gnext, H, m, NGW, lane);
}
__device__ __forceinline__ void ph_ssm_fill(const Args& a, unsigned char* ws, int gtid, int NT) {
    const float *c_re = a.in[12], *c_im = a.in[13];
    const f32x2* POW = WSP(f32x2, WS_POW); const f32x2* BBAR = WSP(f32x2, WS_BBAR); const float* KTAB = WSP(float, WS_KTAB); bf16 *E = WSP(bf16, WS_E), *KG = WSP(bf16, WS_KG);
#pragma unroll 4
    for (int v = gtid; v < NG * 512 * 64; v += NT) {
        const int k8 = v & 63, row = v >> 6, g = row >> 9, tc = row & 511, t = tc >> 4, co = tc & 15, k0 = k8 * 8, s_ = k0 >> 4, ci0 = k0 & 15;
        const bool live = s_ <= t; const int tau = live ? t - s_ : 0;
        const f32x4* kp = (const f32x4*)(KTAB + ((size_t)(g * TCH + tau) * 16 + co) * 16 + ci0); const f32x4 k0v = kp[0], k1v = kp[1];
        v4u w; w.x = pk2(k0v.x, k0v.y); w.y = pk2(k0v.z, k0v.w); w.z = pk2(k1v.x, k1v.y); w.w = pk2(k1v.z, k1v.w);
        if (!live) w = (v4u){0u, 0u, 0u, 0u};
        *(v4u*)(KG + (size_t)row * KX + k0) = w;
    }
#pragma unroll 2
    for (int v = gtid; v < NG * 512 * 16; v += NT) {
        const int k8 = v & 15, row = v >> 4, g = row >> 9, tc = row & 511, t = tc >> 4, co = tc & 15, p0 = k8 * 4;
        float val[8];
#pragma unroll
        for (int j = 0; j < 4; ++j) { const int p = p0 + j; const float cr = c_re[(size_t)(g * 16 + co) * 64 + p], cim = c_im[(size_t)(g * 16 + co) * 64 + p];
            const f32x2 pw = POW[(size_t)(g * 64 + p) * 65 + t + 1];
            val[2 * j] = cr * pw.x - cim * pw.y; val[2 * j + 1] = -(cr * pw.y + cim * pw.x); }
        v4u w; w.x = pk2(val[0], val[1]); w.y = pk2(val[2], val[3]); w.z = pk2(val[4], val[5]); w.w = pk2(val[6], val[7]);
        *(v4u*)(KG + (size_t)row * KX + 512 + 8 * k8) = w;
    }
#pragma unroll 4
    for (int v = gtid; v < NG * 256 * 64; v += NT) {
        const int k8 = v & 63, row = v >> 6, g = row >> 8, n = row & 255, k0 = k8 * 8;
        v4u w = (v4u){0u, 0u, 0u, 0u};
        if (n < 128) { const int p = n >> 1, part = n & 1, s = k0 >> 4, ci0 = k0 & 15; const f32x2 pw = POW[(size_t)(g * 64 + p) * 65 + (TCH - 1 - s)];
            float val[8];
#pragma unroll
            for (int e = 0; e < 8; ++e) { const f32x2 bb = BBAR[(size_t)(g * 64 + p) * 16 + ci0 + e]; val[e] = part == 0 ? (pw.x * bb.x - pw.y * bb.y) : (pw.x * bb.y + pw.y * bb.x); }
            w.x = pk2(val[0], val[1]); w.y = pk2(val[2], val[3]); w.z = pk2(val[4], val[5]); w.w = pk2(val[6], val[7]); }
        *(v4u*)(E + (size_t)row * 512 + k0) = w;
    }
}

__device__ __forceinline__ void ph3_interleaved(const Args& a, unsigned char* ws, int gw, int NGW, int gtid, int NT, int lane) {
    const float *c_re = a.in[12], *c_im = a.in[13];
    const f32x2* POW = WSP(f32x2, WS_POW); const f32x2* BBAR = WSP(f32x2, WS_BBAR); const float* KTAB = WSP(float, WS_KTAB); bf16 *E = WSP(bf16, WS_E), *KG = WSP(bf16, WS_KG);
    const bf16* Y = WSP(bf16, WS_Y); const float* SSQ = WSP(float, WS_SSQ); bf16* H = (bf16*)WSP(float, WS_R2);
    const bf16* XB = WSP(bf16, WS_H);
    { f32x4 kv[8][2];
#pragma unroll
      for (int i = 0; i < 8; ++i) { const int v = gtid + i * NT, k8 = v & 63, row = v >> 6, g = row >> 9, tc = row & 511, t = tc >> 4, co = tc & 15, k0 = k8 * 8, s_ = k0 >> 4, ci0 = k0 & 15;
          const int tau = s_ <= t ? t - s_ : 0; const f32x4* kp = (const f32x4*)(KTAB + ((size_t)(g * TCH + tau) * 16 + co) * 16 + ci0); kv[i][0] = kp[0]; kv[i][1] = kp[1]; }
      row_pass_rows<4, true, true, true>(XB, Y, SSQ, a.in[4], 0.5f, a.out, a.in[5], H, gw, NGW, lane);
      row_pass_rows<4, true, true, true>(XB, Y, SSQ, a.in[4], 0.5f, a.out, a.in[5], H, gw + 4 * NGW, NGW, lane);
#pragma unroll
      for (int i = 0; i < 8; ++i) { const int v = gtid + i * NT, k8 = v & 63, row = v >> 6, tc = row & 511, t = tc >> 4, k0 = k8 * 8, s_ = k0 >> 4;
          v4u w; w.x = pk2(kv[i][0].x, kv[i][0].y); w.y = pk2(kv[i][0].z, kv[i][0].w); w.z = pk2(kv[i][1].x, kv[i][1].y); w.w = pk2(kv[i][1].z, kv[i][1].w);
          if (s_ > t) w = (v4u){0u, 0u, 0u, 0u};
          *(v4u*)(KG + (size_t)row * KX + k0) = w; } }
    { float cr[2][4], ci[2][4]; f32x2 pw[2][4];
#pragma unroll
      for (int i = 0; i < 2; ++i) { const int v = gtid + i * NT, k8 = v & 15, row = v >> 4, g = row >> 9, tc = row & 511, t = tc >> 4, co = tc & 15, p0 = k8 * 4;
#pragma unroll
          for (int j = 0; j < 4; ++j) { const int p = p0 + j; cr[i][j] = c_re[(size_t)(g * 16 + co) * 64 + p]; ci[i][j] = c_im[(size_t)(g * 16 + co) * 64 + p]; pw[i][j] = POW[(size_t)(g * 64 + p) * 65 + t + 1]; } }
      row_pass_rows<4, true, true, true>(XB, Y, SSQ, a.in[4], 0.5f, a.out, a.in[5], H, gw + 8 * NGW, NGW, lane);
#pragma unroll
      for (int i = 0; i < 2; ++i) { const int v = gtid + i * NT, k8 = v & 15, row = v >> 4; float val[8];
#pragma unroll
          for (int j = 0; j < 4; ++j) { val[2 * j] = cr[i][j] * pw[i][j].x - ci[i][j] * pw[i][j].y; val[2 * j + 1] = -(cr[i][j] * pw[i][j].y + ci[i][j] * pw[i][j].x); }
          v4u w; w.x = pk2(val[0], val[1]); w.y = pk2(val[2], val[3]); w.z = pk2(val[4], val[5]); w.w = pk2(val[6], val[7]);
          *(v4u*)(KG + (size_t)row * KX + 512 + 8 * k8) = w; } }
    { f32x2 pw[4], bb[4][8];
#pragma unroll
      for (int i = 0; i < 4; ++i) { const int v = gtid + i * NT, k8 = v & 63, row = v >> 6, g = row >> 8, n = row & 127, k0 = k8 * 8, p = n >> 1, s = k0 >> 4, ci0 = k0 & 15;
          pw[i] = POW[(size_t)(g * 64 + p) * 65 + (TCH - 1 - s)];
#pragma unroll
          for (int e = 0; e < 8; ++e) bb[i][e] = BBAR[(size_t)(g * 64 + p) * 16 + ci0 + e]; }
      row_pass_rows<4, true, true, true>(XB, Y, SSQ, a.in[4], 0.5f, a.out, a.in[5], H, gw + 12 * NGW, NGW, lane);
#pragma unroll
      for (int i = 0; i < 4; ++i) { const int v = gtid + i * NT, k8 = v & 63, row = v >> 6, n = row & 255, k0 = k8 * 8, part = n & 1; float val[8];
#pragma unroll
          for (int e = 0; e < 8; ++e) val[e] = part == 0 ? (pw[i].x * bb[i][e].x - pw[i].y * bb[i][e].y) : (pw[i].x * bb[i][e].y + pw[i].y * bb[i][e].x);
          v4u w; w.x = pk2(val[0], val[1]); w.y = pk2(val[2], val[3]); w.z = pk2(val[4], val[5]); w.w = pk2(val[6], val[7]);
          if (n >= 128) w = (v4u){0u, 0u, 0u, 0u};
          *(v4u*)(E + (size_t)row * 512 + k0) = w; } }
}
__device__ __forceinline__ void ph_mixin(LAS unsigned char* lds, unsigned char* ws, const bf16* X1, int G, int bx) {
    pg8::Gemm g{X1, WSP(bf16, WS_WMIXIN), D, D, D}; pg8::StaticOrder S; S.init(M, NIN, G, bx);
    pg8::EpiQKVU Ep{WSP(bf16, WS_QKV), WSP(bf16, WS_UX), WSP(float, WS_R2)};
    pg8::gemm_phase<pg8::EpiQKVU, pg8::StaticOrder, true, true>(lds, g, S, Ep);
}
__device__ __forceinline__ void ph_s1(LAS unsigned char* lds, unsigned char* ws, int G, int bx) {
    pg8::Gemm g{WSP(bf16, WS_UX), WSP(bf16, WS_E), 512, KX, 512}; pg8::OrderS1 S{G, bx}; pg8::EpiS1 Ep{WSP(float, WS_XEND)};
    pg8::gemm_phase<pg8::EpiS1, pg8::OrderS1, true, true>(lds, g, S, Ep);
}
__device__ __forceinline__ void ph_attn(LAS unsigned char* lds, unsigned char* ws, int G, int bx, int wave, int lane) {
    if (G == 256) {
        const int xcd = bx & 7, slot = bx >> 3;
        for (int i = 0; i < 2; ++i) attn_unit(lds, WSP(bf16, WS_QKV), WSP(bf16, WS_MIX), (xcd * 4 + i * 2 + (slot >> 4)) * 16 + (slot & 15), wave, lane);
    } else
    for (int unit = bx; unit < BATCH * 8 * (SEQ / AT_UTOK); unit += G) attn_unit(lds, WSP(bf16, WS_QKV), WSP(bf16, WS_MIX), unit, wave, lane);
}
__device__ __forceinline__ void ph_carry(LAS unsigned char* lds, unsigned char* ws, int bx, int wave, int lane) {
    for (int ch = bx; ch < 128; ch += (int)gridDim.x) {
        const f32x2* POW = WSP(f32x2, WS_POW); const float* XEND = WSP(float, WS_XEND); bf16* UX = WSP(bf16, WS_UX);
        const int g = ch >> 2, b = ch & 3, p = lane; const f32x2 a1 = POW[(size_t)(g * 64 + p) * 65 + TCH];
        const size_t base = (size_t)g * 1024 + b * 256 + 32 * wave;
        f32x2 e[32];
#pragma unroll
        for (int i = 0; i < 32; ++i) e[i] = *(const f32x2*)(XEND + (base + i) * 128 + 2 * p);
        float tr = 0.f, ti = 0.f;
#pragma unroll
        for (int i = 0; i < 32; ++i) { const float er = e[i].x, ei = e[i].y; e[i] = (f32x2){tr, ti}; const float nr = a1.x * tr - a1.y * ti + er, ni = a1.x * ti + a1.y * tr + ei; tr = nr; ti = ni; }
        LAS f32x2* T = (LAS f32x2*)lds;
        __syncthreads();
        T[wave * 64 + p] = (f32x2){tr, ti};
        f32x2 aS = a1;
#pragma unroll
        for (int k = 0; k < 5; ++k) aS = (f32x2){aS.x * aS.x - aS.y * aS.y, 2.f * aS.x * aS.y};
        __syncthreads();
        float pr = 0.f, pi = 0.f;
        for (int w = 0; w < wave; ++w) { const f32x2 t = T[w * 64 + p]; const float nr = aS.x * pr - aS.y * pi + t.x, ni = aS.x * pi + aS.y * pr + t.y; pr = nr; pi = ni; }
        float qr = pr, qi = pi;
#pragma unroll
        for (int i = 0; i < 32; ++i) {
            *(unsigned*)(UX + (base + i) * KX + 512 + 2 * p) = pk2(e[i].x + qr, e[i].y + qi);
            const float nr = a1.x * qr - a1.y * qi, ni = a1.x * qi + a1.y * qr; qr = nr; qi = ni; }
    }
}
__device__ __forceinline__ void ph_s2(LAS unsigned char* lds, unsigned char* ws, const float* dskip, int G, int bx) {
    pg8::Gemm g{WSP(bf16, WS_UX), WSP(bf16, WS_KG), KX, KX, KX}; pg8::OrderS2 S{G, bx}; pg8::EpiS2 Ep{WSP(bf16, WS_YS)};
    pg8::gemm_phase<pg8::EpiS2, pg8::OrderS2, true, true>(lds, g, S, Ep);
}
__device__ __forceinline__ void ph_glu(LAS unsigned char* lds, unsigned char* ws, const float* bglu, int G, int bx) {
    pg8::Gemm g{WSP(bf16, WS_YS), WSP(bf16, WS_WGLU), 512, 512, 512}; pg8::StaticOrder S; S.init(M, 512, G, bx);
    pg8::EpiGLU Ep{WSP(bf16, WS_YS), bglu, WSP(bf16, WS_MIX)};
    pg8::gemm_phase<pg8::EpiGLU, pg8::StaticOrder, true, true>(lds, g, S, Ep);
}

#ifndef REP_MASK
#define REP_MASK 0u
#endif
#ifndef NSYNC_EXTRA
#define NSYNC_EXTRA 0
#endif
__global__ void __launch_bounds__(512, 2) hybrid_fwd(Args a) {
    extern __shared__ __attribute__((aligned(16))) unsigned char lds_raw[];
    LAS unsigned char* lds = (LAS unsigned char*)lds_raw;
    const int tid = threadIdx.x, lane = tid & 63, wave = __builtin_amdgcn_readfirstlane(tid >> 6);
    const int G = gridDim.x, bx = blockIdx.x, gw = bx * 8 + wave, NGW = G * 8, gtid = bx * 512 + tid, NT = G * 512;
    unsigned char* ws = a.ws;
    const int lo = a.ph_lo, hi = a.ph_hi;
    volatile LAS unsigned* MISC = (volatile LAS unsigned*)(lds + 158720);
    if (tid < 16) MISC[tid] = 0u;
    __syncthreads();
    XcdBarrier bar = xcd_barrier_post((unsigned*)ws, MISC + 8);
#define IN(k) (lo <= (k) && (k) < hi)
#ifndef CG_SEAM
#define CG_SEAM -1
#endif
#define SEAM(k) do { if (lo <= (k) && (k) + 1 < hi) { if ((k) == CG_SEAM) cg::this_grid().sync(); else xcd_barrier(bar); } } while (0)
#define RUN(k, call) do { if (IN(k)) { call; if ((REP_MASK >> (k)) & 1u) { xcd_barrier(bar); call; } } } while (0)
    for (int e_ = 0; e_ < NSYNC_EXTRA; ++e_) xcd_barrier(bar);
#ifndef ONLY_ATTN
    RUN(0, ph_prologue(lds, a, ws, G, bx, tid, lane, wave));
#ifdef REP0
    if (IN(0)) { xcd_barrier(bar); ph_prologue(lds, a, ws, G, bx, tid, lane, wave, REP0); }
#endif
#endif
    SEAM(0);
#ifndef ONLY_ATTN
    RUN(1, ph_ffn_in(lds, ws, WSP(bf16, WS_H), WS_WIN1, WSP(float, WS_R1), G, bx));
#endif
    SEAM(1);
#ifndef ONLY_ATTN
    RUN(2, ph_rowss(lds, ws, WS_ACT, WS_WOUT1, FF, G, bx));
#endif
    SEAM(2);
#ifndef ONLY_ATTN
    static_assert(NG * 512 * 64 == 8 * 256 * 512 && NG * 512 * 16 == 2 * 256 * 512 && NG * 256 * 64 == 4 * 256 * 512 && M == 16 * 256 * 8, "ph3_interleaved counts are for a 256-workgroup grid");
    if (G == 256) { RUN(3, ph3_interleaved(a, ws, gw, NGW, gtid, NT, lane)); }
    else { RUN(3, ((ph_rowpass<true, true, true>(ws, WSP(bf16, WS_H), a.in[4], 0.5f, a.out, a.in[5], gw, NGW, lane)), ph_ssm_fill(a, ws, gtid, NT))); }
#endif
    SEAM(3);
#ifndef ONLY_ATTN
    RUN(4, ph_mixin(lds, ws, (const bf16*)a.out, G, bx));
#endif
    SEAM(4);
#ifndef ONLY_ATTN
    if (G == 256) { if (IN(5)) { ph_s1(lds, ws, G, bx); if (bx >= 128) ph_late_weights(lds, a, ws, (bx - 128) * 8 + wave, 1024, wave, lane);
                                 asm volatile("s_waitcnt vmcnt(0)" ::: "memory"); __syncthreads(); ph_carry(lds, ws, bx, wave, lane); __syncthreads(); ph_attn(lds, ws, G, bx, wave, lane); } }
    else { RUN(5, (ph_s1(lds, ws, G, bx), ph_attn(lds, ws, G, bx, wave, lane))); }
#else
    ph_attn(lds, ws, G, bx, wave, lane);
#endif
    SEAM(5);
#ifndef ONLY_ATTN
    if (G != 256) { RUN(6, ph_carry(lds, ws, bx, wave, lane)); }
#endif
    if (G != 256) SEAM(6);
#ifndef ONLY_ATTN
    RUN(7, ph_s2(lds, ws, a.in[14], G, bx));
#endif
    SEAM(7);
#ifndef ONLY_ATTN
    RUN(8, ph_glu(lds, ws, a.in[16], G, bx));
#endif
    SEAM(8);
#ifndef ONLY_ATTN
    RUN(9, ph_rowss(lds, ws, WS_MIX, WS_WMIXOUT, D, G, bx));
#endif
    SEAM(9);
#ifndef ONLY_ATTN
    RUN(10, (ph_rowpass<true, true, true>(ws, a.out, a.in[18], 1.0f, WSP(bf16, WS_MIX), a.in[19], gw, NGW, lane)));
#endif
    SEAM(10);
#ifndef ONLY_ATTN
    RUN(11, ph_ffn_in(lds, ws, WSP(bf16, WS_MIX), WS_WIN2, WSP(float, WS_R2), G, bx));
#endif
    SEAM(11);
#ifndef ONLY_ATTN
    RUN(12, ph_rowss(lds, ws, WS_ACT, WS_WOUT2, FF, G, bx));
#endif
    SEAM(12);
#ifndef ONLY_ATTN
    RUN(13, (ph_rowpass<true, false>(ws, WSP(bf16, WS_MIX), a.in[22], 0.5f, a.out, nullptr, gw, NGW, lane)));
#endif
#undef IN
#undef SEAM
#undef RUN
}

#ifndef MK_PER_PHASE
#define MK_PER_PHASE 0
#endif
extern "C" void kernel_launch(void* const* d_in, const int* in_sizes, int n_in, void* d_out, int out_size, void* d_ws, size_t ws_size, hipStream_t stream) {
    static int grid = 0;
    if (grid == 0) {
        if (n_in != 23 || out_size != M * D || ws_size < WS_END) { fprintf(stderr, "kernel_launch: unexpected shapes (n_in %d out %d ws %zu)\n", n_in, out_size, ws_size); grid = -1; return; }
        int dev = 0, cus = 0, per_cu = 0;
        (void)hipGetDevice(&dev); (void)hipDeviceGetAttribute(&cus, hipDeviceAttributeMultiprocessorCount, dev);
        if (hipFuncSetAttribute((const void*)hybrid_fwd, hipFuncAttributeMaxDynamicSharedMemorySize, LDS_BYTES) != hipSuccess) { fprintf(stderr, "kernel_launch: hipFuncSetAttribute failed\n"); grid = -1; return; }
        if (hipOccupancyMaxActiveBlocksPerMultiprocessor(&per_cu, (const void*)hybrid_fwd, 512, LDS_BYTES) != hipSuccess || per_cu < 1) { fprintf(stderr, "kernel_launch: occupancy query says %d\n", per_cu); per_cu = 1; }
        (void)hipGetLastError();
        if (per_cu > 1) per_cu = 1;
        grid = cus * per_cu;
    }
    if (grid < 0) return;
    if (hipMemsetAsync(d_ws, 0, 16384, stream) != hipSuccess) { fprintf(stderr, "kernel_launch: memset failed\n"); return; }
    Args a{};
    for (int i = 0; i < 23; ++i) a.in[i] = (const float*)d_in[i];
    a.out = (float*)d_out; a.ws = (unsigned char*)d_ws;
#if MK_PER_PHASE
    for (int ph = 0; ph < NPHASE; ++ph) { a.ph_lo = ph; a.ph_hi = ph + 1; hipLaunchKernelGGL(hybrid_fwd, dim3(grid), dim3(512), LDS_BYTES, stream, a); }
#else
    a.ph_lo = 0; a.ph_hi = NPHASE;
    void* args[] = {&a};
    hipError_t e = hipLaunchCooperativeKernel((const void*)hybrid_fwd, dim3(grid), dim3(512), args, LDS_BYTES, stream);
    if (e != hipSuccess) fprintf(stderr, "cooperative launch failed: %s (grid %d)\n", hipGetErrorString(e), grid);
#endif
}
```

```cpp
#include <hip/hip_runtime.h>
#include <hip/hip_cooperative_groups.h>
#include <cstdio>
#include <cstdint>
namespace pg8 {
#define PG8_LAS __attribute__((address_space(3)))
typedef unsigned short bf16_t;
typedef short bf16x8 __attribute__((ext_vector_type(8)));
typedef float f32x4 __attribute__((ext_vector_type(4)));
typedef unsigned u32x4 __attribute__((ext_vector_type(4)));
constexpr int BM = 256, BK = 64, HALF = 128, HTB = HALF * BK * 2  , STAGE_BYTES = 8 * HTB, NXCD = 8, WGM = 8;

__host__ __device__ __forceinline__ int lds_byte(int r, int c) { const int st = (r >> 4) * 2 + (c >> 5), rr = r & 15, cc = c & 31, ob = rr * 64 + cc * 2; return st * 1024 + (ob ^ (((ob >> 9) & 1) << 5)); }
__host__ __device__ __forceinline__ void stage_rc(int b, int& R, int& C) { const int st = b / 1024, sb = b % 1024, swz = sb ^ (((sb >> 9) & 1) << 5); R = (st >> 1) * 16 + swz / 64; C = (st & 1) * 32 + (swz % 64) / 2; }
__host__ __device__ __forceinline__ int perm32(int rho) { const int n = rho >> 4, i = rho & 15; return 8 * (i >> 2) + 4 * n + (i & 3); }

struct Unit { int pm, pn, pb; };
struct Gemm { const bf16_t* A; const bf16_t* Bt; int K, lda, ldb; };

struct StaticOrder {
    int nM, nN, nwg, G, c;
    __host__ __device__ void init(int M, int N, int G_, int c_) { nM = M / BM; nN = N / BM; nwg = nM * nN; G = G_; c = c_; }
    __host__ __device__ bool next(int i, Unit& u) const {
        const long L = (long)i * G + c; if (L >= nwg) return false;
        int wgid = (int)L; { const int q = nwg / NXCD, r = nwg % NXCD, xcd = wgid % NXCD, off = wgid / NXCD; wgid = (xcd < r ? xcd * (q + 1) : r * (q + 1) + (xcd - r) * q) + off; }
        const int nig = WGM * nN, gid = wgid / nig, fm = gid * WGM, gsz = (nM - fm) < WGM ? (nM - fm) : WGM;
        u.pm = fm + ((wgid % nig) % gsz); u.pn = (wgid % nig) / gsz; u.pb = u.pn; return true;
    }
    __device__ __forceinline__ void a_ready(const Unit&) const {}
    __device__ __forceinline__ void done(const Unit&) const {}
};

__device__ __forceinline__ unsigned cvt_pk_bf16(float lo, float hi) { unsigned r; asm volatile("v_cvt_pk_bf16_f32 %0, %1, %2" : "=v"(r) : "v"(lo), "v"(hi)); return r; }
typedef float f32x2 __attribute__((ext_vector_type(2)));
__device__ __forceinline__ float sigmoidf_(float x) { return __builtin_amdgcn_rcpf(1.0f + __builtin_amdgcn_exp2f(-1.4426950408889634f * x)); }
__device__ __forceinline__ float bf_lo(unsigned w) { return __uint_as_float(w << 16); }
__device__ __forceinline__ float bf_hi(unsigned w) { return __uint_as_float(w & 0xffff0000u); }
__device__ __forceinline__ u32x4 pack8(const f32x4 a, const f32x4 b) { u32x4 w; w.x = cvt_pk_bf16(a[0], a[1]); w.y = cvt_pk_bf16(a[2], a[3]); w.z = cvt_pk_bf16(b[0], b[1]); w.w = cvt_pk_bf16(b[2], b[3]); return w; }

struct EpiSwiGLU {
    static constexpr bool PERM = true, AFTER_DRAIN = false;
    bf16_t* O; int ldc; const float* R2;
    __device__ __forceinline__ void operator()(const f32x4 (&acc)[2][2][4][2], const Unit& u, int wr, int wc, int fr, int fq) const {
        const int row0 = u.pm * BM + wr * 64 + fr, col0 = u.pn * HALF + wc * 32 + 8 * fq;
#pragma unroll
        for (int ai = 0; ai < 2; ++ai)
#pragma unroll
            for (int m = 0; m < 4; ++m) {
                bf16_t* rowp = O + (size_t)(row0 + ai * HALF + m * 16) * ldc + col0;
                const float rs = R2 ? R2[row0 + ai * HALF + m * 16] : 1.0f;
                f32x4 o[2];
#pragma unroll
                for (int n = 0; n < 2; ++n) { const f32x4 g = acc[ai][0][m][n] * rs, up = acc[ai][1][m][n] * rs;
#pragma unroll
                    for (int e = 0; e < 4; ++e) o[n][e] = g[e] * sigmoidf_(g[e]) * up[e]; }
                *(u32x4*)rowp = pack8(o[0], o[1]);
            }
    }
};
struct EpiRowSS {
    static constexpr bool PERM = true, AFTER_DRAIN = false;
    bf16_t* Y; float* SSQ;
    __device__ __forceinline__ void operator()(const f32x4 (&acc)[2][2][4][2], const Unit& u, int wr, int wc, int fr, int fq) const {
        const int row0 = u.pm * BM + wr * 64 + fr, col0 = u.pn * BM + wc * 32 + 8 * fq;
#pragma unroll
        for (int ai = 0; ai < 2; ++ai)
#pragma unroll
            for (int m = 0; m < 4; ++m) {
                const int row = row0 + ai * HALF + m * 16; float s = 0.f;
#pragma unroll
                for (int bj = 0; bj < 2; ++bj) { const f32x4 v0 = acc[ai][bj][m][0], v1 = acc[ai][bj][m][1];
                    s += (v0[0] * v0[0] + v0[1] * v0[1]) + (v0[2] * v0[2] + v0[3] * v0[3]) + (v1[0] * v1[0] + v1[1] * v1[1]) + (v1[2] * v1[2] + v1[3] * v1[3]);
                    *(u32x4*)(Y + (size_t)row * 1024 + col0 + bj * HALF) = pack8(v0, v1); }
                s += __shfl_xor(s, 16); s += __shfl_xor(s, 32);
                if (fq == 0) SSQ[(size_t)row * 16 + u.pn * 4 + wc] = s;
            }
    }
};
struct EpiQKVU {
    static constexpr bool PERM = true, AFTER_DRAIN = false;
    bf16_t* QKV; bf16_t* UX; const float* R2;
    __device__ __forceinline__ void operator()(const f32x4 (&acc)[2][2][4][2], const Unit& u, int wr, int wc, int fr, int fq) const {
        const int row0 = u.pm * BM + wr * 64 + fr, col0 = u.pn * BM + wc * 32 + 8 * fq;
#pragma unroll
        for (int ai = 0; ai < 2; ++ai)
#pragma unroll
            for (int m = 0; m < 4; ++m) {
                const int row = row0 + ai * HALF + m * 16; const float rs = R2[row];
#pragma unroll
                for (int bj = 0; bj < 2; ++bj) { const u32x4 w = pack8(acc[ai][bj][m][0] * rs, acc[ai][bj][m][1] * rs); const int col = col0 + bj * HALF;
                    if (u.pn < 6) *(u32x4*)(QKV + (size_t)row * 1536 + col) = w;
                    else { const int cu = col - 1536, g = cu >> 4, ch = cu & 15, b = row >> 13, t = row & 8191, chunk = t >> 5, s = t & 31;
                        *(u32x4*)(UX + ((size_t)(g * 1024 + b * 256 + chunk) * 640 + s * 16 + ch)) = w; } }
            }
    }
};
struct EpiS1 {
    static constexpr bool PERM = false, AFTER_DRAIN = false;
    float* XEND;
    __device__ __forceinline__ void operator()(const f32x4 (&acc)[2][2][4][2], const Unit& u, int wr, int wc, int fr, int fq) const {
        const int row0 = u.pm * BM + wr * 64 + fr, col0 = wc * 32 + 4 * fq;
#pragma unroll
        for (int ai = 0; ai < 2; ++ai)
#pragma unroll
            for (int m = 0; m < 4; ++m) {
                float* rowp = XEND + (size_t)(row0 + ai * HALF + m * 16) * 128 + col0;
#pragma unroll
                for (int n = 0; n < 2; ++n) *(f32x4*)(rowp + 16 * n) = acc[ai][0][m][n];
            }
    }
};
struct EpiS2 {
    static constexpr bool PERM = true, AFTER_DRAIN = false;
    bf16_t* YS;
    __device__ __forceinline__ void operator()(const f32x4 (&acc)[2][2][4][2], const Unit& u, int wr, int wc, int fr, int fq) const {
        const int g = u.pm >> 2, rl0 = (u.pm & 3) * BM + wr * 64 + fr, col0 = u.pn * BM + wc * 32 + 8 * fq, co0 = col0 & 15;
#pragma unroll
        for (int ai = 0; ai < 2; ++ai)
#pragma unroll
            for (int m = 0; m < 4; ++m) {
                const int rl = rl0 + ai * HALF + m * 16, b = rl >> 8, chunk = rl & 255;
#pragma unroll
                for (int bj = 0; bj < 2; ++bj) { const int col = col0 + bj * HALF, t = col >> 4;
                    f32x4 y0 = acc[ai][bj][m][0], y1 = acc[ai][bj][m][1];
#pragma unroll
                    for (int e = 0; e < 4; ++e) { const float a = y0[e], c = y1[e];
                        y0[e] = a * sigmoidf_(1.5957691216057308f * (a + 0.044715f * a * a * a));
                        y1[e] = c * sigmoidf_(1.5957691216057308f * (c + 0.044715f * c * c * c)); }
                    const size_t token = (size_t)b * 8192 + chunk * 32 + t;
                    *(u32x4*)(YS + token * 512 + g * 16 + co0) = pack8(y0, y1); }
            }
    }
};
struct EpiGLU {
    static constexpr bool PERM = true, AFTER_DRAIN = false;
    const bf16_t* YS; const float* bias; bf16_t* MIX;
    __device__ __forceinline__ void operator()(const f32x4 (&acc)[2][2][4][2], const Unit& u, int wr, int wc, int fr, int fq) const {
        const int row0 = u.pm * BM + wr * 64 + fr, col0 = u.pn * BM + wc * 32 + 8 * fq;
#pragma unroll
        for (int ai = 0; ai < 2; ++ai)
#pragma unroll
            for (int m = 0; m < 4; ++m) {
                const int row = row0 + ai * HALF + m * 16;
#pragma unroll
                for (int bj = 0; bj < 2; ++bj) { const int col = col0 + bj * HALF;
                    const u32x4 yw = *(const u32x4*)(YS + (size_t)row * 512 + col);
                    const f32x4 b0 = *(const f32x4*)(bias + col), b1 = *(const f32x4*)(bias + col + 4);
                    const f32x4 a0 = acc[ai][bj][m][0] + b0, a1 = acc[ai][bj][m][1] + b1; f32x4 o0, o1;
                    o0[0] = bf_lo(yw.x) * sigmoidf_(a0[0]); o0[1] = bf_hi(yw.x) * sigmoidf_(a0[1]); o0[2] = bf_lo(yw.y) * sigmoidf_(a0[2]); o0[3] = bf_hi(yw.y) * sigmoidf_(a0[3]);
                    o1[0] = bf_lo(yw.z) * sigmoidf_(a1[0]); o1[1] = bf_hi(yw.z) * sigmoidf_(a1[1]); o1[2] = bf_lo(yw.w) * sigmoidf_(a1[2]); o1[3] = bf_hi(yw.w) * sigmoidf_(a1[3]);
                    *(u32x4*)(MIX + (size_t)row * 1024 + 512 + col) = pack8(o0, o1); }
            }
    }
};
struct OrderS1 { int G, c;
    __device__ bool next(int i, Unit& u) const { const int L = i * G + c; if (L >= 128) return false; u.pm = L; u.pn = 0; u.pb = L >> 2; return true; }
    __device__ __forceinline__ void a_ready(const Unit&) const {}
    __device__ __forceinline__ void done(const Unit&) const {}
};
struct OrderS2 { int G, c;
    __device__ bool next(int i, Unit& u) const { const int cx = (G == 256) ? ((c & 7) * 32 + (c >> 3)) : c;
        const int L = i * G + cx; if (L >= 256) return false; const int g = L >> 3, r = L & 7; u.pm = g * 4 + (r >> 1); u.pn = r & 1; u.pb = g * 2 + u.pn; return true; }
    __device__ __forceinline__ void a_ready(const Unit&) const {}
    __device__ __forceinline__ void done(const Unit&) const {}
};

template <class Epi, class Sched, bool ALIGN_EPI = false, bool SP2 = false>
__device__ __forceinline__ void gemm_phase(PG8_LAS unsigned char* lds, const Gemm g, const Sched& S, const Epi& E) {
    const int tid = threadIdx.x, wid = __builtin_amdgcn_readfirstlane(tid >> 6), lane = tid & 63, wr = wid >> 2, wc = wid & 3, fr = lane & 15, fq = lane >> 4;
    const int K = g.K, nt = K / BK;
    unsigned voffA[2], voffB[2];
#pragma unroll
    for (int i = 0; i < 2; ++i) { int R, C; stage_rc(tid * 16 + i * 8192, R, C); const int Rb = Epi::PERM ? ((R & ~31) + perm32(R & 31)) : R;
        voffA[i] = (unsigned)(R * g.lda + C) * 2u; voffB[i] = (unsigned)(Rb * g.ldb + C) * 2u; }
    const size_t kstep = (size_t)(BK * 2);
    const size_t hstepA = (size_t)HALF * g.lda * 2, hstepB = (size_t)HALF * g.ldb * 2;
    const size_t tstepA = 2 * hstepA, tstepB = 2 * hstepB;
    const unsigned ldsw = (unsigned)wid * 1024u;
    const int aoff = lds_byte(wr * 64 + fr, fq * 8), boff = lds_byte(wc * 32 + fr, fq * 8);
#define PG8_SA(b, h) (((b) * 2 + (h)) * HTB)
#define PG8_SB(b, h) ((4 + (b) * 2 + (h)) * HTB)
#define PG8_STAGE(bufoff, gbase, voff) do { _Pragma("unroll") for (int _i = 0; _i < 2; ++_i) \
        __builtin_amdgcn_global_load_lds((const unsigned*)((const char*)(gbase) + (voff)[_i]), (PG8_LAS unsigned*)(lds + (bufoff) + ldsw + _i * 8192), 16, 0, 0); } while (0)
#define PG8_LDA(dst, b, h) do { _Pragma("unroll") for (int m = 0; m < 4; ++m) _Pragma("unroll") for (int k = 0; k < 2; ++k) dst[m][k] = *(const PG8_LAS bf16x8*)(lds + PG8_SA(b, h) + aoff + m * 2048 + k * 1024); } while (0)
#define PG8_LDB(dst, b, h) do { _Pragma("unroll") for (int n = 0; n < 2; ++n) _Pragma("unroll") for (int k = 0; k < 2; ++k) dst[n][k] = *(const PG8_LAS bf16x8*)(lds + PG8_SB(b, h) + boff + n * 2048 + k * 1024); } while (0)
#define PG8_MMA(ai, bj, At, Bt) do { __builtin_amdgcn_s_setprio(1); _Pragma("unroll") for (int m = 0; m < 4; ++m) _Pragma("unroll") for (int n = 0; n < 2; ++n) _Pragma("unroll") for (int k = 0; k < 2; ++k) \
        acc[ai][bj][m][n] = __builtin_amdgcn_mfma_f32_16x16x32_bf16(Bt[n][k], At[m][k], acc[ai][bj][m][n], 0, 0, 0); __builtin_amdgcn_s_setprio(0); } while (0)
#define PG8_WAIT_V(n) asm volatile("s_waitcnt vmcnt(" #n ")" ::: "memory")
#define PG8_WAIT_L(n) asm volatile("s_waitcnt lgkmcnt(" #n ")" ::: "memory")
#define PG8_BAR __builtin_amdgcn_s_barrier()
#define PG8_SCHED __builtin_amdgcn_sched_barrier(0)
    Unit cur, nxt; int ui = 0;
    if (!S.next(0, cur)) return;
    f32x4 acc[2][2][4][2];
#pragma unroll
    for (int a = 0; a < 2; ++a)
#pragma unroll
        for (int b = 0; b < 2; ++b)
#pragma unroll
            for (int m = 0; m < 4; ++m)
#pragma unroll
                for (int n = 0; n < 2; ++n) acc[a][b][m][n] = (f32x4){0.f, 0.f, 0.f, 0.f};
    bf16x8 At[4][2], B0[2][2], B1[2][2];
    const char* cA = (const char*)g.A + (size_t)cur.pm * tstepA; const char* cB = (const char*)g.Bt + (size_t)cur.pb * tstepB;
    S.a_ready(cur);
    if constexpr (SP2) {
        PG8_STAGE(PG8_SB(0, 0), cB, voffB); PG8_STAGE(PG8_SB(0, 1), cB + hstepB, voffB); PG8_STAGE(PG8_SA(0, 0), cA, voffA); PG8_STAGE(PG8_SA(0, 1), cA + hstepA, voffA);
        if (wr == 1) PG8_BAR;
        PG8_WAIT_V(2); PG8_BAR;
        PG8_STAGE(PG8_SB(1, 0), cB + kstep, voffB); PG8_STAGE(PG8_SA(1, 0), cA + kstep, voffA); PG8_STAGE(PG8_SB(1, 1), cB + hstepB + kstep, voffB);
        PG8_WAIT_V(6); PG8_BAR;
    } else {
        PG8_STAGE(PG8_SB(0, 0), cB, voffB); PG8_STAGE(PG8_SA(0, 0), cA, voffA); PG8_STAGE(PG8_SB(0, 1), cB + hstepB, voffB); PG8_STAGE(PG8_SA(0, 1), cA + hstepA, voffA);
        if (wr == 1) PG8_BAR;
        PG8_WAIT_V(4); PG8_BAR;
        PG8_STAGE(PG8_SB(1, 0), cB + kstep, voffB); PG8_STAGE(PG8_SA(1, 0), cA + kstep, voffA); PG8_STAGE(PG8_SB(1, 1), cB + hstepB + kstep, voffB);
        PG8_WAIT_V(6); PG8_BAR;
    }
    for (;;) {
        const bool has_next = S.next(ui + 1, nxt);
        const char* nA = has_next ? (const char*)g.A + (size_t)nxt.pm * tstepA : cA; const char* nB = has_next ? (const char*)g.Bt + (size_t)nxt.pb * tstepB : cB;
        for (int t = 0; t < nt; t += 2) {
            const bool last = (t == nt - 2);
            const char* a1 = cA + (size_t)(t + 1) * kstep;
            const char* a2 = last ? nA : cA + (size_t)(t + 2) * kstep; const char* b2 = last ? nB : cB + (size_t)(t + 2) * kstep;
            const char* a3 = a2 + kstep; const char* b3 = b2 + kstep;
            if (last && has_next) S.a_ready(nxt);
            if constexpr (SP2) {
            PG8_LDB(B0, 0, 0); PG8_LDB(B1, 0, 1); PG8_SCHED; PG8_LDA(At, 0, 0); PG8_STAGE(PG8_SA(1, 1), a1 + hstepA, voffA);
            PG8_WAIT_V(8); PG8_WAIT_L(0); PG8_BAR; PG8_MMA(0, 0, At, B0); PG8_MMA(0, 1, At, B1); PG8_BAR; PG8_SCHED;
            PG8_LDA(At, 0, 1); PG8_STAGE(PG8_SB(0, 0), b2, voffB); PG8_STAGE(PG8_SB(0, 1), b2 + hstepB, voffB); PG8_STAGE(PG8_SA(0, 0), a2, voffA);
            PG8_WAIT_V(8); PG8_WAIT_L(0); PG8_BAR; PG8_MMA(1, 0, At, B0); PG8_MMA(1, 1, At, B1); PG8_BAR; PG8_SCHED;
            PG8_LDB(B0, 1, 0); PG8_LDB(B1, 1, 1); PG8_SCHED; PG8_LDA(At, 1, 0); PG8_STAGE(PG8_SA(0, 1), a2 + hstepA, voffA);
            PG8_WAIT_V(8); PG8_WAIT_L(0); PG8_BAR; PG8_MMA(0, 0, At, B0); PG8_MMA(0, 1, At, B1); PG8_BAR; PG8_SCHED;
            PG8_LDA(At, 1, 1); PG8_STAGE(PG8_SB(1, 0), b3, voffB); PG8_STAGE(PG8_SB(1, 1), b3 + hstepB, voffB); PG8_STAGE(PG8_SA(1, 0), a3, voffA);
            PG8_WAIT_V(8); PG8_WAIT_L(0); PG8_BAR; PG8_MMA(1, 0, At, B0); PG8_MMA(1, 1, At, B1); PG8_BAR; PG8_SCHED;
            } else {
            PG8_LDB(B0, 0, 0); PG8_SCHED; PG8_LDA(At, 0, 0); PG8_STAGE(PG8_SA(1, 1), a1 + hstepA, voffA);
            PG8_WAIT_L(8); PG8_BAR; PG8_WAIT_L(0); PG8_MMA(0, 0, At, B0); PG8_BAR; PG8_SCHED;
            PG8_LDB(B1, 0, 1); PG8_STAGE(PG8_SB(0, 0), b2, voffB);
            PG8_BAR; PG8_WAIT_L(0); PG8_MMA(0, 1, At, B1); PG8_BAR;
            PG8_LDA(At, 0, 1); PG8_STAGE(PG8_SA(0, 0), a2, voffA);
            PG8_BAR; PG8_WAIT_L(0); PG8_MMA(1, 0, At, B0); PG8_BAR; PG8_SCHED;
            PG8_STAGE(PG8_SB(0, 1), b2 + hstepB, voffB);
            PG8_WAIT_V(6); PG8_BAR; PG8_MMA(1, 1, At, B1); PG8_BAR;
            PG8_LDB(B0, 1, 0); PG8_SCHED; PG8_LDA(At, 1, 0); PG8_STAGE(PG8_SA(0, 1), a2 + hstepA, voffA);
            PG8_WAIT_L(8); PG8_BAR; PG8_WAIT_L(0); PG8_MMA(0, 0, At, B0); PG8_BAR; PG8_SCHED;
            PG8_LDB(B1, 1, 1); PG8_STAGE(PG8_SB(1, 0), b3, voffB);
            PG8_BAR; PG8_WAIT_L(0); PG8_MMA(0, 1, At, B1); PG8_BAR;
            PG8_LDA(At, 1, 1); PG8_STAGE(PG8_SA(1, 0), a3, voffA);
            PG8_BAR; PG8_WAIT_L(0); PG8_MMA(1, 0, At, B0); PG8_BAR; PG8_SCHED;
            PG8_STAGE(PG8_SB(1, 1), b3 + hstepB, voffB);
            PG8_WAIT_V(6); PG8_BAR; PG8_MMA(1, 1, At, B1); PG8_BAR;
            }
        }
        if constexpr (ALIGN_EPI) { if (wr == 0) PG8_BAR; }
        if constexpr (!Epi::AFTER_DRAIN) { E(acc, cur, wr, wc, fr, fq); S.done(cur); }
        if (!has_next) break;
#pragma unroll
        for (int a = 0; a < 2; ++a)
#pragma unroll
            for (int b = 0; b < 2; ++b)
#pragma unroll
                for (int m = 0; m < 4; ++m)
#pragma unroll
                    for (int n = 0; n < 2; ++n) acc[a][b][m][n] = (f32x4){0.f, 0.f, 0.f, 0.f};
        cur = nxt; cA = nA; cB = nB; ++ui;
        if constexpr (ALIGN_EPI) { if (wr == 1) PG8_BAR; }
    }
    PG8_WAIT_V(0);
    if constexpr (!ALIGN_EPI) { if (wr == 0) PG8_BAR; }
    PG8_BAR;
    if constexpr (Epi::AFTER_DRAIN) { E.fused(acc, cur, wr, wc, fr, fq, lds, wid, lane); S.done(cur); }
#undef PG8_SA
#undef PG8_SB
#undef PG8_STAGE
#undef PG8_LDA
#undef PG8_LDB
#undef PG8_MMA
#undef PG8_WAIT_V
#undef PG8_WAIT_L
#undef PG8_BAR
#undef PG8_SCHED
}
}

namespace cg = cooperative_groups;
#define LAS __attribute__((address_space(3)))
typedef unsigned short bf16;
typedef unsigned v4u __attribute__((ext_vector_type(4)));
typedef unsigned v2u __attribute__((ext_vector_type(2)));
typedef float f32x4 __attribute__((ext_vector_type(4)));
typedef float f32x2 __attribute__((ext_vector_type(2)));

constexpr int D = 1024, BATCH = 4, SEQ = 8192, M = BATCH * SEQ, FF = 2816, NIN = 2048, NG = 32, NP = 64, NC = 16, TCH = 32, NCHUNK = SEQ / TCH;
constexpr float EPS = 1e-6f;
constexpr size_t MiB = 1u << 20;
constexpr size_t WS_WIN1 = 2 * MiB, WS_WOUT1 = 13 * MiB, WS_WMIXIN = 19 * MiB, WS_WGLU = 23 * MiB, WS_WMIXOUT = 24 * MiB, WS_WIN2 = 26 * MiB, WS_WOUT2 = 37 * MiB;
constexpr size_t WS_POW = 43 * MiB, WS_BBAR = 45 * MiB, WS_KTAB = 46 * MiB, WS_SSQ = 48 * MiB, WS_E = 50 * MiB, WS_KG = 66 * MiB;
constexpr size_t WS_H = 138 * MiB, WS_Y = 202 * MiB, WS_MIX = 266 * MiB, WS_ACT = 330 * MiB;
constexpr size_t WS_QKV = 330 * MiB, WS_UX = 426 * MiB, WS_YS = 466 * MiB, WS_XEND = WS_YS  , WS_END = 506 * MiB;
constexpr int KX = 640;
constexpr int LDS_BYTES = 159744;
constexpr int NPHASE = 14;

__device__ __forceinline__ unsigned f2bf(float f) { unsigned u = __builtin_bit_cast(unsigned, f); return (u + 0x7fffu + ((u >> 16) & 1u)) >> 16; }
__device__ __forceinline__ unsigned pk2(float lo, float hi) { return f2bf(lo) | (f2bf(hi) << 16); }
__device__ __forceinline__ float wave_sum(float v) {
#pragma unroll
    for (int o = 1; o < 64; o <<= 1) v += __shfl_xor(v, o);
    return v;
}
#define LDS_WAIT() asm volatile("s_waitcnt lgkmcnt(0)" ::: "memory")

template <bool GK = false> __device__ __forceinline__ void transpose_item(const float* W, int K, int N, bf16* WT, int mode, LAS float* scr, int item, int lane, const float* gk = nullptr) {
    const int nblk = N / 32, kb = item / nblk, nb = item % nblk, k0 = 64 * kb, n0 = 32 * nb;
    int dest0 = n0;
    if (mode == 1) { if (n0 < FF) dest0 = 256 * (n0 / 128) + (n0 % 128); else { const int j0 = n0 - FF; dest0 = 256 * (j0 / 128) + 128 + (j0 % 128); } }
#pragma unroll 8
    for (int i = 0; i < 32; ++i) { const int kk = 2 * i + (lane >> 5); scr[kk * 33 + (lane & 31)] = __builtin_nontemporal_load(W + (size_t)(k0 + kk) * N + n0 + (lane & 31)); }
    LDS_WAIT(); asm volatile("" ::: "memory");
    const int c = lane & 7;
    f32x4 ga = (f32x4){1.f, 1.f, 1.f, 1.f}, gb = ga;
    if (GK) { ga = *(const f32x4*)(gk + k0 + 8 * c); gb = *(const f32x4*)(gk + k0 + 8 * c + 4); }
#pragma unroll
    for (int j = 0; j < 4; ++j) { const int n = (lane >> 3) + 8 * j; const LAS float* s = scr + (8 * c) * 33 + n;
        v4u o; o.x = pk2(s[0 * 33] * ga.x, s[1 * 33] * ga.y); o.y = pk2(s[2 * 33] * ga.z, s[3 * 33] * ga.w); o.z = pk2(s[4 * 33] * gb.x, s[5 * 33] * gb.y); o.w = pk2(s[6 * 33] * gb.z, s[7 * 33] * gb.w);
        *(v4u*)(WT + (size_t)(dest0 + n) * K + k0 + 8 * c) = o; }
    LDS_WAIT(); asm volatile("" ::: "memory");
}
template <int NR> __device__ __forceinline__ void norm_rows_to_bf16(const float* x, const float* g, bf16* H, int m0, int mstride, int lane) {
    f32x4 v[NR][4];
#pragma unroll
    for (int r = 0; r < NR; ++r) { const size_t m = (size_t)m0 + (size_t)r * mstride;
#pragma unroll
        for (int j = 0; j < 4; ++j) v[r][j] = __builtin_nontemporal_load((const f32x4*)(x + m * D) + lane + 64 * j); }
    f32x4 gg[4];
#pragma unroll
    for (int j = 0; j < 4; ++j) gg[j] = ((const f32x4*)g)[lane + 64 * j];
#pragma unroll
    for (int r = 0; r < NR; ++r) { const size_t m = (size_t)m0 + (size_t)r * mstride; float s = 0.f;
#pragma unroll
        for (int j = 0; j < 4; ++j) s += (v[r][j].x * v[r][j].x + v[r][j].y * v[r][j].y) + (v[r][j].z * v[r][j].z + v[r][j].w * v[r][j].w);
        const float rr = 1.0f / sqrtf(wave_sum(s) * (1.f / D) + EPS);
        unsigned long long* o8 = (unsigned long long*)(H + m * D) + lane;
#pragma unroll
        for (int j = 0; j < 4; ++j) o8[64 * j] = (unsigned long long)pk2(v[r][j].x * rr * gg[j].x, v[r][j].y * rr * gg[j].y) | ((unsigned long long)pk2(v[r][j].z * rr * gg[j].z, v[r][j].w * rr * gg[j].w) << 32);
    }
}
__device__ __forceinline__ f32x2 cpow_n(float dt, float are, float aim, int n) {
    double th = (double)n * ((double)dt * (double)aim);
    th -= 6.283185307179586476925 * rint(th * 0.15915494309189533577);
    const float sn = sinf((float)th), cs = cosf((float)th);
    const float mag = expf((float)n * dt * are);
    return (f32x2){mag * cs, mag * sn};
}
__device__ __forceinline__ f32x2 zoh_factor(float dt, float are, float aim) {
    const float lr = dt * are, li = dt * aim;
    const float sh = sinf(0.5f * li), cm1 = -2.0f * sh * sh, sn = sinf(li), cs = 1.0f + cm1;
    const float em1 = expm1f(lr), ex = em1 + 1.0f;
    const float xr = em1 * cs + cm1, xi = ex * sn;
    const float den = 1.0f / (are * are + aim * aim);
    return (f32x2){(xr * are + xi * aim) * den, (xi * are - xr * aim) * den};
}

template <int NR, bool XIN_BF, bool XOUT_BF, bool FOLD = false> __device__ __forceinline__ void row_pass_rows(const void* xin, const bf16* y, const float* ssq, const float* gpost, float scale, void* xout, const float* gnext, bf16* hout, int m0, int mstride, int lane) {
    f32x4 xv[NR][4]; v2u yw[NR][4]; float ss[NR];
#pragma unroll
    for (int r = 0; r < NR; ++r) { const size_t m = (size_t)m0 + (size_t)r * mstride; ss[r] = ssq[m * 16 + (lane & 15)];
#pragma unroll
        for (int j = 0; j < 4; ++j) {
            if (XIN_BF) { const v2u w = __builtin_nontemporal_load((const v2u*)((const bf16*)xin + m * D) + lane + 64 * j); xv[r][j] = (f32x4){__uint_as_float(w.x << 16), __uint_as_float(w.x & 0xffff0000u), __uint_as_float(w.y << 16), __uint_as_float(w.y & 0xffff0000u)}; }
            else xv[r][j] = __builtin_nontemporal_load((const f32x4*)((const float*)xin + m * D) + lane + 64 * j);
            yw[r][j] = __builtin_nontemporal_load((const v2u*)(y + m * D) + lane + 64 * j); } }
    f32x4 gp[4];
#pragma unroll
    for (int j = 0; j < 4; ++j) gp[j] = ((const f32x4*)gpost)[lane + 64 * j];
#pragma unroll
    for (int r = 0; r < NR; ++r) { const size_t m = (size_t)m0 + (size_t)r * mstride;
        float s1 = ss[r]; s1 += __shfl_xor(s1, 1); s1 += __shfl_xor(s1, 2); s1 += __shfl_xor(s1, 4); s1 += __shfl_xor(s1, 8);
        const float rr = scale / sqrtf(s1 * (1.f / D) + EPS); float s2 = 0.f;
#pragma unroll
        for (int j = 0; j < 4; ++j) { f32x4 o; const f32x4 x4 = xv[r][j]; const v2u w = yw[r][j];
            o.x = x4.x + __uint_as_float(w.x << 16) * rr * gp[j].x; o.y = x4.y + __uint_as_float(w.x & 0xffff0000u) * rr * gp[j].y;
            o.z = x4.z + __uint_as_float(w.y << 16) * rr * gp[j].z; o.w = x4.w + __uint_as_float(w.y & 0xffff0000u) * rr * gp[j].w;
            xv[r][j] = o; s2 += (o.x * o.x + o.y * o.y) + (o.z * o.z + o.w * o.w);
            if (XOUT_BF) { v2u ow; ow.x = pk2(o.x, o.y); ow.y = pk2(o.z, o.w); if (FOLD) ((v2u*)((bf16*)xout + m * D))[lane + 64 * j] = ow;   else __builtin_nontemporal_store(ow, (v2u*)((bf16*)xout + m * D) + lane + 64 * j); }
            else __builtin_nontemporal_store(o, (f32x4*)((float*)xout + m * D) + lane + 64 * j); }
        if (FOLD) { const float r2 = 1.0f / sqrtf(wave_sum(s2) * (1.f / D) + EPS); if (lane == 0) ((float*)hout)[m] = r2; }
        else if (gnext) {
            const float r2 = 1.0f / sqrtf(wave_sum(s2) * (1.f / D) + EPS);
            unsigned long long* o8 = (unsigned long long*)(hout + m * D) + lane;
#pragma unroll
            for (int j = 0; j < 4; ++j) { const f32x4 gg = ((const f32x4*)gnext)[lane + 64 * j]; const f32x4 v = xv[r][j];
                o8[64 * j] = (unsigned long long)pk2(v.x * r2 * gg.x, v.y * r2 * gg.y) | ((unsigned long long)pk2(v.z * r2 * gg.z, v.w * r2 * gg.w) << 32); }
        }
    }
}

typedef short bf16x8_t __attribute__((ext_vector_type(8)));
typedef short s16x4_t __attribute__((ext_vector_type(4)));
constexpr int AT_UTOK = 512;
constexpr int AT_OPITCH = 72;
constexpr int AT_O_OFF = 0, AT_ML_OFF = AT_UTOK * AT_OPITCH * 2, AT_V_OFF = AT_ML_OFF + AT_UTOK * 8, AT_VROW = 144, AT_VWAVE = 32 * AT_VROW;
constexpr int AT_K_OFF = AT_V_OFF + 8 * AT_VWAVE;
static_assert(AT_K_OFF + 8 * AT_VWAVE <= 158720, "attention LDS map");
__device__ __forceinline__ s16x4_t tr_read16(LAS unsigned char* p) { return __builtin_bit_cast(s16x4_t, __builtin_amdgcn_ds_read_tr16_b64_v4i16((LAS s16x4_t*)p)); }
__device__ __forceinline__ unsigned cvtpk(float lo, float hi) { typedef float f2 __attribute__((ext_vector_type(2))); typedef __bf16 b2 __attribute__((ext_vector_type(2))); f2 v = {lo, hi}; b2 b = __builtin_convertvector(v, b2); return __builtin_bit_cast(unsigned, b); }

__device__ __forceinline__ float xmax16(float v) { auto r = __builtin_amdgcn_permlane16_swap(__float_as_uint(v), __float_as_uint(v), false, false); return fmaxf(__uint_as_float(r[0]), __uint_as_float(r[1])); }
__device__ __forceinline__ float xmax32(float v) { auto r = __builtin_amdgcn_permlane32_swap(__float_as_uint(v), __float_as_uint(v), false, false); return fmaxf(__uint_as_float(r[0]), __uint_as_float(r[1])); }
__device__ __forceinline__ float xadd16(float v) { auto r = __builtin_amdgcn_permlane16_swap(__float_as_uint(v), __float_as_uint(v), false, false); return __uint_as_float(r[0]) + __uint_as_float(r[1]); }
__device__ __forceinline__ float xadd32(float v) { auto r = __builtin_amdgcn_permlane32_swap(__float_as_uint(v), __float_as_uint(v), false, false); return __uint_as_float(r[0]) + __uint_as_float(r[1]); }
constexpr float AT_MFLOOR = -1.0e4f;
template <int BR, int NU, int PF> __device__ __forceinline__ void attn_jobN(const bf16* QKVb, int h, int Tq0, LAS unsigned char* vst, f32x4 (&o)[NU][4], float (&m_out)[NU], float (&l_out)[NU], int lane) {
    constexpr int DIL = BR == 0 ? 1 : (BR == 1 ? 4 : 16), SMIN = BR == 0 ? 0 : 33, NSTEP = (128 - SMIN + 16 * NU + 31) / 32;
    const int fr = lane & 15, fq = lane >> 4;
    const float slope2 = exp2f(-(float)(h + 1)) * 1.4426950408889634f * (float)DIL;
    const char* qb = (const char*)QKVb;
    bf16x8_t qf[NU][2];
#pragma unroll
    for (int u = 0; u < NU; ++u) { const unsigned qoff = (unsigned)(Tq0 + DIL * (16 * u + fr)) * 3072u + (unsigned)(h * 128 + 16 * fq);
#pragma unroll
      for (int ks = 0; ks < 2; ++ks) { const v4u w = *(const v4u*)(qb + (qoff + 64u * ks)); const float c = 0.18033688011112042f; v4u sv;
          sv.x = cvtpk(c * __uint_as_float(w.x << 16), c * __uint_as_float(w.x & 0xffff0000u)); sv.y = cvtpk(c * __uint_as_float(w.y << 16), c * __uint_as_float(w.y & 0xffff0000u));
          sv.z = cvtpk(c * __uint_as_float(w.z << 16), c * __uint_as_float(w.z & 0xffff0000u)); sv.w = cvtpk(c * __uint_as_float(w.w << 16), c * __uint_as_float(w.w & 0xffff0000u));
          qf[u][ks] = __builtin_bit_cast(bf16x8_t, sv); } }
    const int Tk0 = Tq0 - 128 * DIL;
    const int sbase = 128 + fr - 4 * fq;
    float A0[8];
#pragma unroll
    for (int e = 0; e < 8; ++e) { const int sr = sbase - (e & 3); float lg = 0.f; if (BR <= 1 && (sr & 3) == 0) lg = 1.0f; if (BR == 0 && (sr & 15) == 0) lg = 1.5849625007211562f;
        A0[e] = lg - slope2 * (float)(sbase - 16 * (e >> 2) - (e & 3)); }
    const int kmin = Tk0 < 0 ? (-Tk0 + DIL - 1) / DIL : 0;
    float m[NU], l[NU];
#pragma unroll
    for (int u = 0; u < NU; ++u) { m[u] = AT_MFLOOR; l[u] = 0.f;
#pragma unroll
        for (int db = 0; db < 4; ++db) o[u][db] = (f32x4){0.f, 0.f, 0.f, 0.f}; }
    const unsigned kvcol = (unsigned)(1024 + h * 128 + 16 * (lane & 7));
    LAS unsigned char* vwr = vst + (lane >> 3) * AT_VROW + (lane & 7) * 16;
    LAS unsigned char* vrd = vst + (4 * fq + (fr >> 2)) * AT_VROW + 8 * (fr & 3);
    LAS unsigned char* kwr = vwr + (AT_K_OFF - AT_V_OFF);
    LAS unsigned char* krd = vst + (AT_K_OFF - AT_V_OFF) + fr * AT_VROW + 16 * fq;
    v4u kreg[PF][4], vreg[PF][4];
#define AT_CLAMP(t) ((t) < 0 ? 0 : ((t) > SEQ - 1 ? SEQ - 1 : (t)))
#define AT_LOAD(step, BUF) do { \
        _Pragma("unroll") for (int i = 0; i < 4; ++i) { const int tv = Tk0 + DIL * (32 * (step) + (lane >> 3) + 8 * i); const unsigned ro = (unsigned)AT_CLAMP(tv) * 3072u + kvcol; \
            kreg[BUF][i] = *(const v4u*)(qb + ro); vreg[BUF][i] = *(const v4u*)(qb + (ro + 1024u)); } \
    } while (0)
    AT_LOAD(NSTEP - 1, 0);
    if (PF == 2) AT_LOAD(NSTEP - 2, PF - 1);
#pragma unroll (PF == 2 ? NSTEP : 1)
    for (int step = NSTEP - 1; step >= 0; --step) {
        const int buf = PF == 2 ? ((NSTEP - 1 - step) & 1) : 0;
#pragma unroll
        for (int i = 0; i < 4; ++i) { *(LAS v4u*)(kwr + 8 * i * AT_VROW) = kreg[buf][i]; *(LAS v4u*)(vwr + 8 * i * AT_VROW) = vreg[buf][i]; }
        const bf16x8_t kf0 = *(LAS bf16x8_t*)(krd), kf1 = *(LAS bf16x8_t*)(krd + 64), kf2 = *(LAS bf16x8_t*)(krd + 16 * AT_VROW), kf3 = *(LAS bf16x8_t*)(krd + 16 * AT_VROW + 64);
        const float bst = slope2 * (float)(32 * step);
        const bool edge = (32 * step < 16 * NU) || (32 * step + 31 > 128 - SMIN) || (32 * step < kmin);
        bf16x8_t pf[NU];
#pragma unroll
        for (int u = 0; u < NU; ++u) {
            const float c0 = bst - m[u] - slope2 * (float)(16 * u);
            f32x4 sA = (f32x4){c0, c0, c0, c0}, sB = sA;
            sA = __builtin_amdgcn_mfma_f32_16x16x32_bf16(kf0, qf[u][0], sA, 0, 0, 0); sA = __builtin_amdgcn_mfma_f32_16x16x32_bf16(kf1, qf[u][1], sA, 0, 0, 0);
            sB = __builtin_amdgcn_mfma_f32_16x16x32_bf16(kf2, qf[u][0], sB, 0, 0, 0); sB = __builtin_amdgcn_mfma_f32_16x16x32_bf16(kf3, qf[u][1], sB, 0, 0, 0);
            float sc[8];
#pragma unroll
            for (int e = 0; e < 8; ++e) sc[e] = ((e < 4) ? sA[e & 3] : sB[e & 3]) + A0[e];
            if (edge) {
                const int klo = (fr + 16 * u) > kmin ? (fr + 16 * u) : kmin, khi = 128 + 16 * u + fr - SMIN;
#pragma unroll
                for (int e = 0; e < 8; ++e) { const int kap = 32 * step + 16 * (e >> 2) + 4 * fq + (e & 3); if (kap < klo || kap > khi) sc[e] = -INFINITY; }
            }
            float mx = fmaxf(fmaxf(fmaxf(sc[0], sc[1]), fmaxf(sc[2], sc[3])), fmaxf(fmaxf(sc[4], sc[5]), fmaxf(sc[6], sc[7])));
            mx = xmax16(mx); mx = xmax32(mx);
            if (__builtin_amdgcn_ballot_w64(mx > 0.f) != 0ull) {
                const float dl = fmaxf(mx, 0.f), corr = __builtin_amdgcn_exp2f(-dl);
                m[u] += dl; l[u] *= corr;
#pragma unroll
                for (int e = 0; e < 8; ++e) sc[e] -= dl;
#pragma unroll
                for (int db = 0; db < 4; ++db) o[u][db] = o[u][db] * corr;
            }
            float ps = 0.f;
#pragma unroll
            for (int e = 0; e < 8; ++e) { sc[e] = __builtin_amdgcn_exp2f(sc[e]); ps += sc[e]; }
            l[u] += ps;
            v4u pw; pw.x = cvtpk(sc[0], sc[1]); pw.y = cvtpk(sc[2], sc[3]); pw.z = cvtpk(sc[4], sc[5]); pw.w = cvtpk(sc[6], sc[7]);
            pf[u] = __builtin_bit_cast(bf16x8_t, pw);
            if (NU > 2) __builtin_amdgcn_sched_barrier(0);
        }
        if (NU > 2) __builtin_amdgcn_sched_barrier(0);
        if (step >= PF) { if (buf == 0) AT_LOAD(step - PF, 0); else AT_LOAD(step - PF, PF - 1); }
#pragma unroll
        for (int db = 0; db < 4; ++db) {
            if (NU > 2) __builtin_amdgcn_sched_barrier(0);
            const s16x4_t va = tr_read16(vrd + db * 32), vb = tr_read16(vrd + 16 * AT_VROW + db * 32);
            const bf16x8_t vf = (bf16x8_t){va[0], va[1], va[2], va[3], vb[0], vb[1], vb[2], vb[3]};
#pragma unroll
            for (int u = 0; u < NU; ++u) o[u][db] = __builtin_amdgcn_mfma_f32_16x16x32_bf16(vf, pf[u], o[u][db], 0, 0, 0);
        }
        if (NU > 2 || PF == 2) __builtin_amdgcn_sched_barrier(0);
    }
#undef AT_LOAD
#undef AT_CLAMP
#pragma unroll
    for (int u = 0; u < NU; ++u) { float lv = l[u]; lv = xadd16(lv); lv = xadd32(lv); m_out[u] = m[u]; l_out[u] = lv; }
}
template <int MODE> __device__ __forceinline__ void attn_merge(LAS unsigned char* lds, int lq, f32x4 (&o)[4], float m, float l, bf16* orow  , int lane) {
    const int fq = lane >> 4;
    LAS bf16* Ol = (LAS bf16*)(lds + AT_O_OFF) + lq * AT_OPITCH + 4 * fq;
    LAS float* Ml = (LAS float*)(lds + AT_ML_OFF); LAS float* Ll = Ml + AT_UTOK;
    if (MODE != 0) {
        const float mo = Ml[lq], lo = Ll[lq]; const float mn = fmaxf(mo, m), a = __builtin_amdgcn_exp2f(mo - mn), b = __builtin_amdgcn_exp2f(m - mn);
#pragma unroll
        for (int db = 0; db < 4; ++db) { const v2u w = *(LAS v2u*)(Ol + 16 * db);
            const f32x4 oo = (f32x4){__uint_as_float(w.x << 16), __uint_as_float(w.x & 0xffff0000u), __uint_as_float(w.y << 16), __uint_as_float(w.y & 0xffff0000u)};
            o[db] = oo * a + o[db] * b; }
        l = lo * a + l * b; m = mn;
    }
    if (MODE != 2) {
#pragma unroll
        for (int db = 0; db < 4; ++db) { v2u w; w.x = cvtpk(o[db][0], o[db][1]); w.y = cvtpk(o[db][2], o[db][3]); *(LAS v2u*)(Ol + 16 * db) = w; }
        if (fq == 0) { Ml[lq] = m; Ll[lq] = l; }
    } else {
        const float rl = 1.0f / l;
#pragma unroll
        for (int db = 0; db < 4; ++db) { v2u w; w.x = cvtpk(o[db][0] * rl, o[db][1] * rl); w.y = cvtpk(o[db][2] * rl, o[db][3] * rl); *(v2u*)(orow + 16 * db + 4 * fq) = w; }
    }
}
__device__ __forceinline__ void attn_unit(LAS unsigned char* lds, const bf16* QKV, bf16* MIX, int unit, int wave, int lane) {
    const int b = unit >> 7, h = (unit >> 4) & 7, U0 = (unit & 15) * AT_UTOK, fr = lane & 15;
    const bf16* QKVb = QKV + (size_t)b * SEQ * 1536; bf16* MIXb = MIX + (size_t)b * SEQ * 1024 + h * 64;
    LAS unsigned char* vst = lds + AT_V_OFF + wave * AT_VWAVE;
#pragma unroll 1
    for (int j = wave; j < 16; j += 8) { f32x4 o[2][4]; float m[2], l[2]; const int q0 = 32 * j;
      int ln = lane; asm volatile("" : "+v"(ln));
      attn_jobN<0, 2, 2>(QKVb, h, U0 + q0, vst, o, m, l, ln);
      if (j == wave) __syncthreads();
#pragma unroll
      for (int u = 0; u < 2; ++u) attn_merge<0>(lds, q0 + 16 * u + fr, o[u], m[u], l[u], nullptr, lane); }
#pragma unroll 1
    for (int j = wave; j < 16; j += 8) { f32x4 o[2][4]; float m[2], l[2]; const int q0 = (j & 3) + 128 * (j >> 2);
      int ln = lane; asm volatile("" : "+v"(ln));
      attn_jobN<1, 2, 2>(QKVb, h, U0 + q0, vst, o, m, l, ln);
      if (j == wave) __syncthreads();
#pragma unroll
      for (int u = 0; u < 2; ++u) attn_merge<1>(lds, q0 + 4 * (16 * u + fr), o[u], m[u], l[u], nullptr, lane); }
#pragma unroll 1
    for (int j = wave; j < 16; j += 8) { f32x4 o[2][4]; float m[2], l[2];
      int ln = lane; asm volatile("" : "+v"(ln));
      attn_jobN<2, 2, 2>(QKVb, h, U0 + j, vst, o, m, l, ln);
      if (j == wave) __syncthreads();
#pragma unroll
      for (int u = 0; u < 2; ++u) { const int lq = j + 16 * (16 * u + fr); attn_merge<2>(lds, lq, o[u], m[u], l[u], MIXb + (size_t)(U0 + lq) * 1024, lane); } }
}

#define RLX_AGENT __ATOMIC_RELAXED, __HIP_MEMORY_SCOPE_AGENT
#define XB_TMO      128
#define XB_XCNT(j)  (256  + 64 * (j))
#define XB_XSUB(j)  (1280 + 64 * (j))
#define XB_XGEN(j)  (2304 + 64 * (j))
#define XB_TOP      3328
#define XB_TOPGEN   3392
#define XCD_BAR_WORDS 3456
#define XB_SPIN_CAP (1u << 18)

__device__ __forceinline__ unsigned xb_ld(unsigned* p)              { return __hip_atomic_load(p, __ATOMIC_RELAXED, __HIP_MEMORY_SCOPE_AGENT); }
__device__ __forceinline__ unsigned xb_add(unsigned* p, unsigned v) { return __hip_atomic_fetch_add(p, v, __ATOMIC_RELAXED, __HIP_MEMORY_SCOPE_AGENT); }
__device__ __forceinline__ unsigned xb_xcc_id() { return (unsigned)__builtin_amdgcn_s_getreg((3 << 11) | 20) & 0xFu; }
#define XB_SPIN(cond, bar) do { unsigned _sp = 0; while (cond) { __builtin_amdgcn_s_sleep(1); \
    if ((++_sp & 255u) == 0u) { if (xb_ld(&(bar)[XB_TMO])) break; if (_sp > XB_SPIN_CAP) { atomicAdd(&(bar)[XB_TMO], 1u); break; } } } } while (0)

struct XcdBarrier {
    unsigned* bar; unsigned x;
    volatile LAS unsigned* st;
};

__device__ __forceinline__ XcdBarrier xcd_barrier_post(unsigned* bar, volatile LAS unsigned* st) {
    XcdBarrier b; b.bar = bar; b.x = xb_xcc_id(); b.st = st;
    if (threadIdx.x == 0) (void)xb_add(&bar[XB_XCNT(b.x)], 1u);
    return b;
}
__device__ __forceinline__ void xcd_barrier_complete(unsigned* bar, unsigned x, unsigned& nloc, unsigned& nx) {
    const unsigned G = gridDim.x * gridDim.y * gridDim.z;
    unsigned sum, cnt, mine, sp = 0u;
    for (;;) {
        sum = 0u; cnt = 0u; mine = 0u;
#pragma unroll
        for (unsigned j = 0; j < 16; ++j) { const unsigned c = xb_ld(&bar[XB_XCNT(j)]); sum += c; cnt += (c > 0u) ? 1u : 0u; mine = (j == x) ? c : mine; }
        if (sum == G) break;
        __builtin_amdgcn_s_sleep(1);
        if ((++sp & 255u) == 0u) { if (xb_ld(&bar[XB_TMO])) break; if (sp > XB_SPIN_CAP) { atomicAdd(&bar[XB_TMO], 1u); break; } }
    }
    nloc = mine > 0u ? mine : 1u; nx = cnt > 0u ? cnt : 1u;
}

__device__ __forceinline__ void xcd_barrier(const XcdBarrier& b) {
    asm volatile("s_waitcnt vmcnt(0)" ::: "memory");
    __syncthreads();
    if (threadIdx.x == 0) {
        unsigned* bar = b.bar;
        __builtin_amdgcn_s_waitcnt(0);
        unsigned nloc = b.st[0], nx = b.st[1];
        if (nloc == 0u) { xcd_barrier_complete(bar, b.x, nloc, nx); b.st[0] = nloc; b.st[1] = nx; }
        const unsigned old = xb_add(&bar[XB_XSUB(b.x)], 1u);
        const unsigned gen = old / nloc;
        if (old + 1u == (gen + 1u) * nloc) {
            __builtin_amdgcn_fence(__ATOMIC_RELEASE, "agent");
            asm volatile("s_waitcnt vmcnt(0)" ::: "memory");
            const unsigned og = xb_add(&bar[XB_TOP], 1u);
            const unsigned tg = og / nx;
            if (og + 1u == (tg + 1u) * nx) xb_add(&bar[XB_TOPGEN], 1u);
            else XB_SPIN(xb_ld(&bar[XB_TOPGEN]) == tg, bar);
            __builtin_amdgcn_fence(__ATOMIC_ACQUIRE, "agent");
            xb_add(&bar[XB_XGEN(b.x)], 1u);
            asm volatile("s_waitcnt vmcnt(0)" ::: "memory");
        } else {
            XB_SPIN(xb_ld(&bar[XB_XGEN(b.x)]) == gen, bar);
            __builtin_amdgcn_fence(__ATOMIC_ACQUIRE, "agent");
            asm volatile("s_waitcnt vmcnt(0)" ::: "memory");
        }
    }
    __syncthreads();
}
struct Args { const float* in[23]; float* out; unsigned char* ws; int ph_lo, ph_hi; };


#define WSP(T, off) ((T*)(ws + (off)))
__device__ __forceinline__ void ph_prologue(LAS unsigned char* lds, const Args& a, unsigned char* ws, int G, int bx, int tid, int lane, int wave, int parts = 7) {
    const int gw = bx * 8 + wave, NGW = G * 8;
    const float *a_re = a.in[7], *a_im = a.in[8], *log_dt = a.in[9], *b_re = a.in[10], *b_im = a.in[11], *c_re = a.in[12], *c_im = a.in[13];
    f32x2* POW = WSP(f32x2, WS_POW); f32x2* BBAR = WSP(f32x2, WS_BBAR); float* KTAB = WSP(float, WS_KTAB);
    if (parts & 1)
    for (int unit = bx; unit < 128; unit += G) {
        const int g = unit >> 2, tb = unit & 3;
        LAS f32x2* powL = (LAS f32x2*)lds;
        LAS f32x2* bbL = (LAS f32x2*)(lds + 4096);
        __syncthreads();
        LAS f32x2* cL = (LAS f32x2*)(lds + 12288);
#pragma unroll
        for (int e = 0; e < 2; ++e) { const int idx = tid + 512 * e; cL[idx] = (f32x2){c_re[(size_t)g * 1024 + idx], c_im[(size_t)g * 1024 + idx]}; }
        const float dt = expf(log_dt[g]);
        { const int p = tid >> 3, j = tid & 7; const float are = a_re[g * 64 + p], aim = a_im[g * 64 + p];
          const f32x2 pw = cpow_n(dt, are, aim, 8 * tb + j); powL[p * 8 + j] = pw; POW[(size_t)(g * 64 + p) * 65 + 8 * tb + j] = pw;
          if (tb == 3 && j == 0) POW[(size_t)(g * 64 + p) * 65 + TCH] = cpow_n(dt, are, aim, TCH);
          const f32x2 z = zoh_factor(dt, are, aim);
#pragma unroll
          for (int e = 0; e < 2; ++e) { const int ci = 2 * j + e; const float br = b_re[(size_t)(g * 64 + p) * 16 + ci], bi = b_im[(size_t)(g * 64 + p) * 16 + ci];
              const f32x2 bb = (f32x2){z.x * br - z.y * bi, z.x * bi + z.y * br}; bbL[p * 16 + ci] = bb; if (tb == 0) BBAR[(size_t)(g * 64 + p) * 16 + ci] = bb; } }
        __syncthreads();
        { const int cc = tid & 255, co = cc >> 4, ci = cc & 15;
          for (int jj = 0; jj < 4; ++jj) { const int j = (tid >> 8) + 2 * jj; float acc = 0.f;
#pragma unroll 8
              for (int p = 0; p < 64; ++p) { const f32x2 cv = cL[co * 64 + p];
                  const f32x2 pw = powL[p * 8 + j], bb = bbL[p * 16 + ci];
                  const float tr = pw.x * bb.x - pw.y * bb.y, ti = pw.x * bb.y + pw.y * bb.x;
                  acc += cv.x * tr - cv.y * ti; }
              if (8 * tb + j == 0 && co == ci) acc += a.in[14][g * 16 + co];
              KTAB[((size_t)(g * TCH + 8 * tb + j) * 16 + co) * 16 + ci] = acc; } }
        __syncthreads();
    }
    LAS float* scr = (LAS float*)(lds + wave * 16384);
    constexpr int I_IN = (D / 64) * (2 * FF / 32), I_OUT = (FF / 64) * (D / 32), I_MI = (D / 64) * (NIN / 32), I_GLU = (512 / 64) * (512 / 32), I_MO = (D / 64) * (D / 32);
    constexpr int NITEMS = 2 * I_IN + 2 * I_OUT + I_MI + I_GLU + I_MO;
    const bool bal = (G == 256); const int nvid = bal ? (bx < 128 ? 2 : 5) : 1, V = bal ? 7168 : NGW, vid0 = bal ? (bx < 128 ? gw * 2 : 2048 + (gw - 1024) * 5) : gw;
    const int nitems0 = bal ? (I_IN + I_OUT + I_MI) : NITEMS;
    if (parts & 2)
    for (int kv = 0; kv < nvid; ++kv)
    for (int it = vid0 + kv; it < nitems0; it += V) {
        int r = it;
        if (r < I_IN) { transpose_item(a.in[2], D, 2 * FF, WSP(bf16, WS_WIN1), 1, scr, r, lane); continue; } r -= I_IN;
        if (r < I_OUT) { transpose_item(a.in[3], FF, D, WSP(bf16, WS_WOUT1), 0, scr, r, lane); continue; } r -= I_OUT;
        if (r < I_MI) { transpose_item<true>(a.in[6], D, NIN, WSP(bf16, WS_WMIXIN), 0, scr, r, lane, a.in[5]); continue; } r -= I_MI;
        if (r < I_GLU) { transpose_item(a.in[15], 512, 512, WSP(bf16, WS_WGLU), 0, scr, r, lane); continue; } r -= I_GLU;
        if (r < I_MO) { transpose_item(a.in[17], D, D, WSP(bf16, WS_WMIXOUT), 0, scr, r, lane); continue; } r -= I_MO;
        if (r < I_IN) { transpose_item<true>(a.in[20], D, 2 * FF, WSP(bf16, WS_WIN2), 1, scr, r, lane, a.in[19]); continue; } r -= I_IN;
        transpose_item(a.in[21], FF, D, WSP(bf16, WS_WOUT2), 0, scr, r, lane);
    }
    const float* x = a.in[0]; const float* g1 = a.in[1]; bf16* H = WSP(bf16, WS_H);
    if (parts & 4)
    for (int kv = 0; kv < nvid; ++kv) { int m = vid0 + kv;
      for (; m + 3 * V < M; m += 4 * V) norm_rows_to_bf16<4>(x, g1, H, m, V, lane);
      for (; m < M; m += V) norm_rows_to_bf16<1>(x, g1, H, m, V, lane); }
}
__device__ __forceinline__ void ph_late_weights(LAS unsigned char* lds, const Args& a, unsigned char* ws, int w0, int nw, int wave, int lane) {
    LAS float* scr = (LAS float*)(lds + wave * 16384);
    constexpr int I_IN = (D / 64) * (2 * FF / 32), I_OUT = (FF / 64) * (D / 32), I_GLU = (512 / 64) * (512 / 32), I_MO = (D / 64) * (D / 32);
    for (int it = w0; it < I_GLU + I_MO + I_IN + I_OUT; it += nw) {
        int r = it;
        if (r < I_GLU) { transpose_item(a.in[15], 512, 512, WSP(bf16, WS_WGLU), 0, scr, r, lane); continue; } r -= I_GLU;
        if (r < I_MO) { transpose_item(a.in[17], D, D, WSP(bf16, WS_WMIXOUT), 0, scr, r, lane); continue; } r -= I_MO;
        if (r < I_IN) { transpose_item<true>(a.in[20], D, 2 * FF, WSP(bf16, WS_WIN2), 1, scr, r, lane, a.in[19]); continue; } r -= I_IN;
        transpose_item(a.in[21], FF, D, WSP(bf16, WS_WOUT2), 0, scr, r, lane);
    }
}
__device__ __forceinline__ void ph_ffn_in(LAS unsigned char* lds, unsigned char* ws, const bf16* A, size_t w_off, const float* R2, int G, int bx) {
    pg8::Gemm g{A, WSP(bf16, w_off), D, D, D}; pg8::StaticOrder S; S.init(M, 2 * FF, G, bx);
    pg8::EpiSwiGLU Ep{WSP(bf16, WS_ACT), FF, R2};
    pg8::gemm_phase<pg8::EpiSwiGLU, pg8::StaticOrder, true, true>(lds, g, S, Ep);
}
__device__ __forceinline__ void ph_rowss(LAS unsigned char* lds, unsigned char* ws, size_t a_off, size_t w_off, int K, int G, int bx) {
    pg8::Gemm g{WSP(bf16, a_off), WSP(bf16, w_off), K, K, K}; pg8::StaticOrder S; S.init(M, D, G, bx);
    pg8::EpiRowSS Ep{WSP(bf16, WS_Y), WSP(float, WS_SSQ)};
    pg8::gemm_phase<pg8::EpiRowSS, pg8::StaticOrder, true, true>(lds, g, S, Ep);
}
template <bool XIN_BF, bool XOUT_BF, bool FOLD = false> __device__ __forceinline__ void ph_rowpass(unsigned char* ws, const void* xin, const float* gpost, float scale, void* out, const float* gnext, int gw, int NGW, int lane) {
    const bf16* Y = WSP(bf16, WS_Y); const float* SSQ = WSP(float, WS_SSQ); bf16* H = WSP(bf16, WS_H);
    int m = gw;
    for (; m + 3 * NGW < M; m += 4 * NGW) row_pass_rows<4, XIN_BF, XOUT_BF, FOLD>(xin, Y, SSQ, gpost, scale, out, gnext, H, m, NGW, lane);
    for (; m < M; m += NGW) row_pass_rows<1, XIN_BF, XOUT_BF, FOLD>(xin, Y, SSQ, gpost, scale, out, gnext, H, m, NGW, lane);
}
__device__ __forceinline__ void ph_ssm_fill(const Args& a, unsigned char* ws, int gtid, int NT) {
    const float *c_re = a.in[12], *c_im = a.in[13];
    const f32x2* POW = WSP(f32x2, WS_POW); const f32x2* BBAR = WSP(f32x2, WS_BBAR); const float* KTAB = WSP(float, WS_KTAB); bf16 *E = WSP(bf16, WS_E), *KG = WSP(bf16, WS_KG);
#pragma unroll 4
    for (int v = gtid; v < NG * 512 * 64; v += NT) {
        const int k8 = v & 63, row = v >> 6, g = row >> 9, tc = row & 511, t = tc >> 4, co = tc & 15, k0 = k8 * 8, s_ = k0 >> 4, ci0 = k0 & 15;
        const bool live = s_ <= t; const int tau = live ? t - s_ : 0;
        const f32x4* kp = (const f32x4*)(KTAB + ((size_t)(g * TCH + tau) * 16 + co) * 16 + ci0); const f32x4 k0v = kp[0], k1v = kp[1];
        v4u w; w.x = pk2(k0v.x, k0v.y); w.y = pk2(k0v.z, k0v.w); w.z = pk2(k1v.x, k1v.y); w.w = pk2(k1v.z, k1v.w);
        if (!live) w = (v4u){0u, 0u, 0u, 0u};
        *(v4u*)(KG + (size_t)row * KX + k0) = w;
    }
#pragma unroll 2
    for (int v = gtid; v < NG * 512 * 16; v += NT) {
        const int k8 = v & 15, row = v >> 4, g = row >> 9, tc = row & 511, t = tc >> 4, co = tc & 15, p0 = k8 * 4;
        float val[8];
#pragma unroll
        for (int j = 0; j < 4; ++j) { const int p = p0 + j; const float cr = c_re[(size_t)(g * 16 + co) * 64 + p], cim = c_im[(size_t)(g * 16 + co) * 64 + p];
            const f32x2 pw = POW[(size_t)(g * 64 + p) * 65 + t + 1];
            val[2 * j] = cr * pw.x - cim * pw.y; val[2 * j + 1] = -(cr * pw.y + cim * pw.x); }
        v4u w; w.x = pk2(val[0], val[1]); w.y = pk2(val[2], val[3]); w.z = pk2(val[4], val[5]); w.w = pk2(val[6], val[7]);
        *(v4u*)(KG + (size_t)row * KX + 512 + 8 * k8) = w;
    }
#pragma unroll 4
    for (int v = gtid; v < NG * 256 * 64; v += NT) {
        const int k8 = v & 63, row = v >> 6, g = row >> 8, n = row & 255, k0 = k8 * 8;
        v4u w = (v4u){0u, 0u, 0u, 0u};
        if (n < 128) { const int p = n >> 1, part = n & 1, s = k0 >> 4, ci0 = k0 & 15; const f32x2 pw = POW[(size_t)(g * 64 + p) * 65 + (TCH - 1 - s)];
            float val[8];
#pragma unroll
            for (int e = 0; e < 8; ++e) { const f32x2 bb = BBAR[(size_t)(g * 64 + p) * 16 + ci0 + e]; val[e] = part == 0 ? (pw.x * bb.x - pw.y * bb.y) : (pw.x * bb.y + pw.y * bb.x); }
            w.x = pk2(val[0], val[1]); w.y = pk2(val[2], val[3]); w.z = pk2(val[4], val[5]); w.w = pk2(val[6], val[7]); }
        *(v4u*)(E + (size_t)row * 512 + k0) = w;
    }
}

__device__ __forceinline__ void ph3_interleaved(const Args& a, unsigned char* ws, int gw, int NGW, int gtid, int NT, int lane) {
    const float *c_re = a.in[12], *c_im = a.in[13];
    const f32x2* POW = WSP(f32x2, WS_POW); const f32x2* BBAR = WSP(f32x2, WS_BBAR); const float* KTAB = WSP(float, WS_KTAB); bf16 *E = WSP(bf16, WS_E), *KG = WSP(bf16, WS_KG);
    const bf16* Y = WSP(bf16, WS_Y); const float* SSQ = WSP(float, WS_SSQ); bf16* H = WSP(bf16, WS_H);
    { f32x4 kv[8][2];
#pragma unroll
      for (int i = 0; i < 8; ++i) { const int v = gtid + i * NT, k8 = v & 63, row = v >> 6, g = row >> 9, tc = row & 511, t = tc >> 4, co = tc & 15, k0 = k8 * 8, s_ = k0 >> 4, ci0 = k0 & 15;
          const int tau = s_ <= t ? t - s_ : 0; const f32x4* kp = (const f32x4*)(KTAB + ((size_t)(g * TCH + tau) * 16 + co) * 16 + ci0); kv[i][0] = kp[0]; kv[i][1] = kp[1]; }
      row_pass_rows<4, false, true, true>(a.in[0], Y, SSQ, a.in[4], 0.5f, a.out, a.in[5], H, gw, NGW, lane);
      row_pass_rows<4, false, true, true>(a.in[0], Y, SSQ, a.in[4], 0.5f, a.out, a.in[5], H, gw + 4 * NGW, NGW, lane);
#pragma unroll
      for (int i = 0; i < 8; ++i) { const int v = gtid + i * NT, k8 = v & 63, row = v >> 6, tc = row & 511, t = tc >> 4, k0 = k8 * 8, s_ = k0 >> 4;
          v4u w; w.x = pk2(kv[i][0].x, kv[i][0].y); w.y = pk2(kv[i][0].z, kv[i][0].w); w.z = pk2(kv[i][1].x, kv[i][1].y); w.w = pk2(kv[i][1].z, kv[i][1].w);
          if (s_ > t) w = (v4u){0u, 0u, 0u, 0u};
          *(v4u*)(KG + (size_t)row * KX + k0) = w; } }
    { float cr[2][4], ci[2][4]; f32x2 pw[2][4];
#pragma unroll
      for (int i = 0; i < 2; ++i) { const int v = gtid + i * NT, k8 = v & 15, row = v >> 4, g = row >> 9, tc = row & 511, t = tc >> 4, co = tc & 15, p0 = k8 * 4;
#pragma unroll
          for (int j = 0; j < 4; ++j) { const int p = p0 + j; cr[i][j] = c_re[(size_t)(g * 16 + co) * 64 + p]; ci[i][j] = c_im[(size_t)(g * 16 + co) * 64 + p]; pw[i][j] = POW[(size_t)(g * 64 + p) * 65 + t + 1]; } }
      row_pass_rows<4, false, true, true>(a.in[0], Y, SSQ, a.in[4], 0.5f, a.out, a.in[5], H, gw + 8 * NGW, NGW, lane);
#pragma unroll
      for (int i = 0; i < 2; ++i) { const int v = gtid + i * NT, k8 = v & 15, row = v >> 4; float val[8];
#pragma unroll
          for (int j = 0; j < 4; ++j) { val[2 * j] = cr[i][j] * pw[i][j].x - ci[i][j] * pw[i][j].y; val[2 * j + 1] = -(cr[i][j] * pw[i][j].y + ci[i][j] * pw[i][j].x); }
          v4u w; w.x = pk2(val[0], val[1]); w.y = pk2(val[2], val[3]); w.z = pk2(val[4], val[5]); w.w = pk2(val[6], val[7]);
          *(v4u*)(KG + (size_t)row * KX + 512 + 8 * k8) = w; } }
    { f32x2 pw[4], bb[4][8];
#pragma unroll
      for (int i = 0; i < 4; ++i) { const int v = gtid + i * NT, k8 = v & 63, row = v >> 6, g = row >> 8, n = row & 127, k0 = k8 * 8, p = n >> 1, s = k0 >> 4, ci0 = k0 & 15;
          pw[i] = POW[(size_t)(g * 64 + p) * 65 + (TCH - 1 - s)];
#pragma unroll
          for (int e = 0; e < 8; ++e) bb[i][e] = BBAR[(size_t)(g * 64 + p) * 16 + ci0 + e]; }
      row_pass_rows<4, false, true, true>(a.in[0], Y, SSQ, a.in[4], 0.5f, a.out, a.in[5], H, gw + 12 * NGW, NGW, lane);
#pragma unroll
      for (int i = 0; i < 4; ++i) { const int v = gtid + i * NT, k8 = v & 63, row = v >> 6, n = row & 255, k0 = k8 * 8, part = n & 1; float val[8];
#pragma unroll
          for (int e = 0; e < 8; ++e) val[e] = part == 0 ? (pw[i].x * bb[i][e].x - pw[i].y * bb[i][e].y) : (pw[i].x * bb[i][e].y + pw[i].y * bb[i][e].x);
          v4u w; w.x = pk2(val[0], val[1]); w.y = pk2(val[2], val[3]); w.z = pk2(val[4], val[5]); w.w = pk2(val[6], val[7]);
          if (n >= 128) w = (v4u){0u, 0u, 0u, 0u};
          *(v4u*)(E + (size_t)row * 512 + k0) = w; } }
}
__device__ __forceinline__ void ph_mixin(LAS unsigned char* lds, unsigned char* ws, const bf16* X1, int G, int bx) {
    pg8::Gemm g{X1, WSP(bf16, WS_WMIXIN), D, D, D}; pg8::StaticOrder S; S.init(M, NIN, G, bx);
    pg8::EpiQKVU Ep{WSP(bf16, WS_QKV), WSP(bf16, WS_UX), WSP(float, WS_H)};
    pg8::gemm_phase<pg8::EpiQKVU, pg8::StaticOrder, true, true>(lds, g, S, Ep);
}
__device__ __forceinline__ void ph_s1(LAS unsigned char* lds, unsigned char* ws, int G, int bx) {
    pg8::Gemm g{WSP(bf16, WS_UX), WSP(bf16, WS_E), 512, KX, 512}; pg8::OrderS1 S{G, bx}; pg8::EpiS1 Ep{WSP(float, WS_XEND)};
    pg8::gemm_phase<pg8::EpiS1, pg8::OrderS1, true, true>(lds, g, S, Ep);
}
__device__ __forceinline__ void ph_attn(LAS unsigned char* lds, unsigned char* ws, int G, int bx, int wave, int lane) {
    if (G == 256) {
        const int xcd = bx & 7, slot = bx >> 3;
        for (int i = 0; i < 2; ++i) attn_unit(lds, WSP(bf16, WS_QKV), WSP(bf16, WS_MIX), (xcd * 4 + i * 2 + (slot >> 4)) * 16 + (slot & 15), wave, lane);
    } else
    for (int unit = bx; unit < BATCH * 8 * (SEQ / AT_UTOK); unit += G) attn_unit(lds, WSP(bf16, WS_QKV), WSP(bf16, WS_MIX), unit, wave, lane);
}
__device__ __forceinline__ void ph_carry(LAS unsigned char* lds, unsigned char* ws, int bx, int wave, int lane) {
    for (int ch = bx; ch < 128; ch += (int)gridDim.x) {
        const f32x2* POW = WSP(f32x2, WS_POW); const float* XEND = WSP(float, WS_XEND); bf16* UX = WSP(bf16, WS_UX);
        const int g = ch >> 2, b = ch & 3, p = lane; const f32x2 a1 = POW[(size_t)(g * 64 + p) * 65 + TCH];
        const size_t base = (size_t)g * 1024 + b * 256 + 32 * wave;
        f32x2 e[32];
#pragma unroll
        for (int i = 0; i < 32; ++i) e[i] = *(const f32x2*)(XEND + (base + i) * 128 + 2 * p);
        float tr = 0.f, ti = 0.f;
#pragma unroll
        for (int i = 0; i < 32; ++i) { const float er = e[i].x, ei = e[i].y; e[i] = (f32x2){tr, ti}; const float nr = a1.x * tr - a1.y * ti + er, ni = a1.x * ti + a1.y * tr + ei; tr = nr; ti = ni; }
        LAS f32x2* T = (LAS f32x2*)lds;
        __syncthreads();
        T[wave * 64 + p] = (f32x2){tr, ti};
        f32x2 aS = a1;
#pragma unroll
        for (int k = 0; k < 5; ++k) aS = (f32x2){aS.x * aS.x - aS.y * aS.y, 2.f * aS.x * aS.y};
        __syncthreads();
        float pr = 0.f, pi = 0.f;
        for (int w = 0; w < wave; ++w) { const f32x2 t = T[w * 64 + p]; const float nr = aS.x * pr - aS.y * pi + t.x, ni = aS.x * pi + aS.y * pr + t.y; pr = nr; pi = ni; }
        float qr = pr, qi = pi;
#pragma unroll
        for (int i = 0; i < 32; ++i) {
            *(unsigned*)(UX + (base + i) * KX + 512 + 2 * p) = pk2(e[i].x + qr, e[i].y + qi);
            const float nr = a1.x * qr - a1.y * qi, ni = a1.x * qi + a1.y * qr; qr = nr; qi = ni; }
    }
}
__device__ __forceinline__ void ph_s2(LAS unsigned char* lds, unsigned char* ws, const float* dskip, int G, int bx) {
    pg8::Gemm g{WSP(bf16, WS_UX), WSP(bf16, WS_KG), KX, KX, KX}; pg8::OrderS2 S{G, bx}; pg8::EpiS2 Ep{WSP(bf16, WS_YS)};
    pg8::gemm_phase<pg8::EpiS2, pg8::OrderS2, true, true>(lds, g, S, Ep);
}
__device__ __forceinline__ void ph_glu(LAS unsigned char* lds, unsigned char* ws, const float* bglu, int G, int bx) {
    pg8::Gemm g{WSP(bf16, WS_YS), WSP(bf16, WS_WGLU), 512, 512, 512}; pg8::StaticOrder S; S.init(M, 512, G, bx);
    pg8::EpiGLU Ep{WSP(bf16, WS_YS), bglu, WSP(bf16, WS_MIX)};
    pg8::gemm_phase<pg8::EpiGLU, pg8::StaticOrder, true, true>(lds, g, S, Ep);
}

#ifndef REP_MASK
#define REP_MASK 0u
#endif
#ifndef NSYNC_EXTRA
#define NSYNC_EXTRA 0
#endif
__global__ void __launch_bounds__(512, 2) hybrid_fwd(Args a) {
    extern __shared__ __attribute__((aligned(16))) unsigned char lds_raw[];
    LAS unsigned char* lds = (LAS unsigned char*)lds_raw;
    const int tid = threadIdx.x, lane = tid & 63, wave = __builtin_amdgcn_readfirstlane(tid >> 6);
    const int G = gridDim.x, bx = blockIdx.x, gw = bx * 8 + wave, NGW = G * 8, gtid = bx * 512 + tid, NT = G * 512;
    unsigned char* ws = a.ws;
    const int lo = a.ph_lo, hi = a.ph_hi;
    volatile LAS unsigned* MISC = (volatile LAS unsigned*)(lds + 158720);
    if (tid < 16) MISC[tid] = 0u;
    __syncthreads();
    XcdBarrier bar = xcd_barrier_post((unsigned*)ws, MISC + 8);
#define IN(k) (lo <= (k) && (k) < hi)
#ifndef CG_SEAM
#define CG_SEAM -1
#endif
#define SEAM(k) do { if (lo <= (k) && (k) + 1 < hi) { if ((k) == CG_SEAM) cg::this_grid().sync(); else xcd_barrier(bar); } } while (0)
#define RUN(k, call) do { if (IN(k)) { call; if ((REP_MASK >> (k)) & 1u) { xcd_barrier(bar); call; } } } while (0)
    for (int e_ = 0; e_ < NSYNC_EXTRA; ++e_) xcd_barrier(bar);
#ifndef ONLY_ATTN
    RUN(0, ph_prologue(lds, a, ws, G, bx, tid, lane, wave));
#ifdef REP0
    if (IN(0)) { xcd_barrier(bar); ph_prologue(lds, a, ws, G, bx, tid, lane, wave, REP0); }
#endif
#endif
    SEAM(0);
#ifndef ONLY_ATTN
    RUN(1, ph_ffn_in(lds, ws, WSP(bf16, WS_H), WS_WIN1, nullptr, G, bx));
#endif
    SEAM(1);
#ifndef ONLY_ATTN
    RUN(2, ph_rowss(lds, ws, WS_ACT, WS_WOUT1, FF, G, bx));
#endif
    SEAM(2);
#ifndef ONLY_ATTN
    static_assert(NG * 512 * 64 == 8 * 256 * 512 && NG * 512 * 16 == 2 * 256 * 512 && NG * 256 * 64 == 4 * 256 * 512 && M == 16 * 256 * 8, "ph3_interleaved counts are for a 256-workgroup grid");
    if (G == 256) { RUN(3, ph3_interleaved(a, ws, gw, NGW, gtid, NT, lane)); }
    else { RUN(3, ((ph_rowpass<false, true, true>(ws, a.in[0], a.in[4], 0.5f, a.out, a.in[5], gw, NGW, lane)), ph_ssm_fill(a, ws, gtid, NT))); }
#endif
    SEAM(3);
#ifndef ONLY_ATTN
    RUN(4, ph_mixin(lds, ws, (const bf16*)a.out, G, bx));
#endif
    SEAM(4);
#ifndef ONLY_ATTN
    if (G == 256) { if (IN(5)) { ph_s1(lds, ws, G, bx); if (bx >= 128) ph_late_weights(lds, a, ws, (bx - 128) * 8 + wave, 1024, wave, lane);
                                 asm volatile("s_waitcnt vmcnt(0)" ::: "memory"); __syncthreads(); ph_carry(lds, ws, bx, wave, lane); __syncthreads(); ph_attn(lds, ws, G, bx, wave, lane); } }
    else { RUN(5, (ph_s1(lds, ws, G, bx), ph_attn(lds, ws, G, bx, wave, lane))); }
#else
    ph_attn(lds, ws, G, bx, wave, lane);
#endif
    SEAM(5);
#ifndef ONLY_ATTN
    if (G != 256) { RUN(6, ph_carry(lds, ws, bx, wave, lane)); }
#endif
    if (G != 256) SEAM(6);
#ifndef ONLY_ATTN
    RUN(7, ph_s2(lds, ws, a.in[14], G, bx));
#endif
    SEAM(7);
#ifndef ONLY_ATTN
    RUN(8, ph_glu(lds, ws, a.in[16], G, bx));
#endif
    SEAM(8);
#ifndef ONLY_ATTN
    RUN(9, ph_rowss(lds, ws, WS_MIX, WS_WMIXOUT, D, G, bx));
#endif
    SEAM(9);
#ifndef ONLY_ATTN
    RUN(10, (ph_rowpass<true, true, true>(ws, a.out, a.in[18], 1.0f, WSP(bf16, WS_MIX), a.in[19], gw, NGW, lane)));
#endif
    SEAM(10);
#ifndef ONLY_ATTN
    RUN(11, ph_ffn_in(lds, ws, WSP(bf16, WS_MIX), WS_WIN2, WSP(float, WS_H), G, bx));
#endif
    SEAM(11);
#ifndef ONLY_ATTN
    RUN(12, ph_rowss(lds, ws, WS_ACT, WS_WOUT2, FF, G, bx));
#endif
    SEAM(12);
#ifndef ONLY_ATTN
    RUN(13, (ph_rowpass<true, false>(ws, WSP(bf16, WS_MIX), a.in[22], 0.5f, a.out, nullptr, gw, NGW, lane)));
#endif
#undef IN
#undef SEAM
#undef RUN
}

#ifndef MK_PER_PHASE
#define MK_PER_PHASE 0
#endif
extern "C" void kernel_launch(void* const* d_in, const int* in_sizes, int n_in, void* d_out, int out_size, void* d_ws, size_t ws_size, hipStream_t stream) {
    static int grid = 0;
    if (grid == 0) {
        if (n_in != 23 || out_size != M * D || ws_size < WS_END) { fprintf(stderr, "kernel_launch: unexpected shapes (n_in %d out %d ws %zu)\n", n_in, out_size, ws_size); grid = -1; return; }
        int dev = 0, cus = 0, per_cu = 0;
        (void)hipGetDevice(&dev); (void)hipDeviceGetAttribute(&cus, hipDeviceAttributeMultiprocessorCount, dev);
        if (hipFuncSetAttribute((const void*)hybrid_fwd, hipFuncAttributeMaxDynamicSharedMemorySize, LDS_BYTES) != hipSuccess) { fprintf(stderr, "kernel_launch: hipFuncSetAttribute failed\n"); grid = -1; return; }
        if (hipOccupancyMaxActiveBlocksPerMultiprocessor(&per_cu, (const void*)hybrid_fwd, 512, LDS_BYTES) != hipSuccess || per_cu < 1) { fprintf(stderr, "kernel_launch: occupancy query says %d\n", per_cu); per_cu = 1; }
        (void)hipGetLastError();
        if (per_cu > 1) per_cu = 1;
        grid = cus * per_cu;
    }
    if (grid < 0) return;
    if (hipMemsetAsync(d_ws, 0, 16384, stream) != hipSuccess) { fprintf(stderr, "kernel_launch: memset failed\n"); return; }
    Args a{};
    for (int i = 0; i < 23; ++i) a.in[i] = (const float*)d_in[i];
    a.out = (float*)d_out; a.ws = (unsigned char*)d_ws;
#if MK_PER_PHASE
    for (int ph = 0; ph < NPHASE; ++ph) { a.ph_lo = ph; a.ph_hi = ph + 1; hipLaunchKernelGGL(hybrid_fwd, dim3(grid), dim3(512), LDS_BYTES, stream, a); }
#else
    a.ph_lo = 0; a.ph_hi = NPHASE;
    void* args[] = {&a};
    hipError_t e = hipLaunchCooperativeKernel((const void*)hybrid_fwd, dim3(grid), dim3(512), args, LDS_BYTES, stream);
    if (e != hipSuccess) fprintf(stderr, "cooperative launch failed: %s (grid %d)\n", hipGetErrorString(e), grid);
#endif
}
```
